# Optimizing an MI355X kernel written in HIP

```python
import jax, jax.numpy as jnp
from jax import lax
import numpy as np

D_MODEL = 2048
BATCH = 8
SEQ = 2048
DEPTH = 2

CHUNK = 64
Q_BLOCK = 128
NORM_EPS = 1e-6
ROPE_THETA = 10000.0
MASK_VALUE = -1e30

HG_HEADS = 4
HG_DK = 128
HG_DV = 128
HG_WIDTH = HG_HEADS * HG_DV

SB_HEADS = 6
SB_DH = 128
SB_WIDTH = SB_HEADS * SB_DH

MLA_HEADS = 6
MLA_NOPE = 128
MLA_ROPE = 64
MLA_V = 128
MLA_Q_RANK = 512
MLA_KV_RANK = 256
MLA_WIDTH = MLA_HEADS * MLA_V

MIX_WIDTH = HG_WIDTH + SB_WIDTH + MLA_WIDTH
IN_SIZES = (HG_HEADS * HG_DK, HG_HEADS * HG_DK, HG_WIDTH, HG_WIDTH,
            SB_WIDTH, SB_WIDTH, SB_WIDTH, MLA_Q_RANK, MLA_KV_RANK + MLA_ROPE)
IN_COLS = 4 * HG_WIDTH + 3 * SB_WIDTH + MLA_Q_RANK + MLA_KV_RANK + MLA_ROPE
D_FF = ((8 * D_MODEL + 3 * 256 - 1) // (3 * 256)) * 256

kernel_name = 'hybrid_hgrn2_stickbreak_mla_block'


def rmsnorm(x, g):
    xf = x.astype(jnp.float32)
    y = xf * lax.rsqrt(jnp.mean(xf * xf, axis=-1, keepdims=True) + NORM_EPS)
    return (y * g.astype(jnp.float32)).astype(x.dtype)


def group_rmsnorm(x, g, n_heads):
    b, s, w = x.shape
    xf = x.astype(jnp.float32).reshape(b, s, n_heads, w // n_heads)
    y = xf * lax.rsqrt(jnp.mean(xf * xf, axis=-1, keepdims=True) + NORM_EPS)
    return (y.reshape(b, s, w) * g.astype(jnp.float32)).astype(x.dtype)


def rope_angles(positions):
    inv_freq = ROPE_THETA ** (-jnp.arange(0, MLA_ROPE, 2, dtype=jnp.float32) / MLA_ROPE)
    ang = positions.astype(jnp.float32)[..., None] * inv_freq
    return jnp.cos(ang), jnp.sin(ang)


def apply_rope(x, cos, sin):
    xf = x.astype(jnp.float32)
    x1, x2 = xf[..., : MLA_ROPE // 2], xf[..., MLA_ROPE // 2:]
    return jnp.concatenate([x1 * cos - x2 * sin, x2 * cos + x1 * sin], axis=-1).astype(x.dtype)


def hgrn2_mixer(q, f_pre, v, lower_bound):
    b, s, _ = q.shape
    n_chunks = s // CHUNK
    lb = lower_bound.astype(jnp.float32)
    fp = f_pre.astype(jnp.float32)
    f = lb + (1.0 - lb) * jax.nn.sigmoid(fp)
    log_f = jnp.log(f)
    k = (1.0 - lb) * jax.nn.sigmoid(-fp)

    def to_chunks(t, d):
        return t.astype(jnp.float32).reshape(b, n_chunks, CHUNK, HG_HEADS, d).transpose(1, 0, 3, 2, 4)

    qc, kc, vc = to_chunks(q, HG_DK), to_chunks(k, HG_DK), to_chunks(v, HG_DV)
    gc = jnp.cumsum(to_chunks(log_f, HG_DK), axis=3)
    causal = jnp.tril(jnp.ones((CHUNK, CHUNK), dtype=bool))[:, :, None]

    def step(state, inp):
        q_c, k_c, v_c, g_c = inp
        diff = g_c[:, :, :, None, :] - g_c[:, :, None, :, :]
        decay = jnp.where(causal, jnp.exp(jnp.where(causal, diff, 0.0)), 0.0)
        scores = jnp.einsum('bhtk,bhsk,bhtsk->bhts', q_c, k_c, decay)
        o = jnp.einsum('bhts,bhsv->bhtv', scores, v_c) + jnp.einsum('bhtk,bhkv->bhtv', q_c * jnp.exp(g_c), state)
        g_last = g_c[:, :, -1:, :]
        state = jnp.exp(g_last)[:, :, 0, :, None] * state + jnp.einsum('bhsk,bhsv->bhkv', k_c * jnp.exp(g_last - g_c), v_c)
        return state, o

    s0 = jnp.zeros((b, HG_HEADS, HG_DK, HG_DV), jnp.float32)
    _, o = lax.scan(step, s0, (qc, kc, vc, gc))
    return o.transpose(1, 0, 3, 2, 4).reshape(b, s, HG_WIDTH).astype(q.dtype)


def stick_breaking_mixer(q, k, v):
    b, s, h, d = q.shape
    scale = d ** -0.5
    outs = []
    for blk in range(s // Q_BLOCK):
        t0, t1 = blk * Q_BLOCK, (blk + 1) * Q_BLOCK
        z = jnp.einsum('bthd,bshd->bhts', q[:, t0:t1], k[:, :t1]).astype(jnp.float32) * scale
        strict = jnp.arange(t1)[None, :] < jnp.arange(t0, t1)[:, None]
        log_keep = jnp.where(strict, jax.nn.log_sigmoid(-z), 0.0)
        between = lax.cumsum(log_keep, axis=3, reverse=True) - log_keep
        a = jnp.where(strict, jnp.exp(jnp.where(strict, jax.nn.log_sigmoid(z) + between, 0.0)), 0.0)
        outs.append(jnp.einsum('bhts,bshd->bthd', a, v[:, :t1].astype(jnp.float32)))
    return jnp.concatenate(outs, axis=1).reshape(b, s, h * d).astype(q.dtype)


def mla_mixer(c_q, c_kv_rope, positions, q_norm_g, w_uq, kv_norm_g, w_ukv):
    b, s, _ = c_q.shape
    q = (rmsnorm(c_q, q_norm_g) @ w_uq).reshape(b, s, MLA_HEADS, MLA_NOPE + MLA_ROPE)
    q_nope, q_rope = q[..., :MLA_NOPE], q[..., MLA_NOPE:]
    c_kv, k_rope = c_kv_rope[..., :MLA_KV_RANK], c_kv_rope[..., MLA_KV_RANK:]
    kv = (rmsnorm(c_kv, kv_norm_g) @ w_ukv).reshape(b, s, MLA_HEADS, MLA_NOPE + MLA_V)
    k_nope, v = kv[..., :MLA_NOPE], kv[..., MLA_NOPE:]
    cos, sin = rope_angles(positions)
    q_rope = apply_rope(q_rope, cos[:, :, None, :], sin[:, :, None, :])
    k_rope = apply_rope(k_rope, cos, sin)
    scale = (MLA_NOPE + MLA_ROPE) ** -0.5
    chunk_id = jnp.arange(s) // CHUNK
    outs = []
    for blk in range(s // Q_BLOCK):
        t0, t1 = blk * Q_BLOCK, (blk + 1) * Q_BLOCK
        sc = (jnp.einsum('bthd,bshd->bhts', q_nope[:, t0:t1], k_nope[:, :t1])
              + jnp.einsum('bthr,bsr->bhts', q_rope[:, t0:t1], k_rope[:, :t1])).astype(jnp.float32) * scale
        allowed = chunk_id[None, :t1] <= chunk_id[t0:t1, None]
        p = jax.nn.softmax(jnp.where(allowed, sc, MASK_VALUE), axis=-1)
        outs.append(jnp.einsum('bhts,bshd->bthd', p, v[:, :t1].astype(jnp.float32)))
    return jnp.concatenate(outs, axis=1).reshape(b, s, MLA_WIDTH).astype(c_q.dtype)


def setup_inputs(seed: int = 0) -> dict:
    key = jax.random.key(seed)
    ks = jax.random.split(key, 20)
    f32 = jnp.float32

    def w(k, shape, fan_in):
        return jax.random.normal(k, shape, f32) * (fan_in ** -0.5)

    def gain(k, shape):
        return 1.0 + 0.02 * jax.random.normal(k, shape, f32)

    x = jax.random.normal(ks[0], (BATCH, SEQ, D_MODEL), f32)
    offsets = jax.random.randint(ks[1], (BATCH, 1), 0, 64, dtype=jnp.int32) * CHUNK
    positions = (offsets + jnp.arange(SEQ, dtype=jnp.int32)[None, :]).astype(jnp.int32)
    return {
        'x': x,
        'positions': positions,
        'attn_norm_g': gain(ks[2], (DEPTH, D_MODEL)),
        'w_in': w(ks[3], (DEPTH, D_MODEL, IN_COLS), D_MODEL),
        'hg_lower_bounds': 1.0 + 0.1 * jax.random.normal(ks[4], (DEPTH, HG_HEADS * HG_DK), f32),
        'hg_norm_g': gain(ks[5], (DEPTH, HG_WIDTH)),
        'sb_norm_g': gain(ks[6], (DEPTH, SB_WIDTH)),
        'mla_q_norm_g': gain(ks[7], (DEPTH, MLA_Q_RANK)),
        'mla_w_uq': w(ks[8], (DEPTH, MLA_Q_RANK, MLA_HEADS * (MLA_NOPE + MLA_ROPE)), MLA_Q_RANK),
        'mla_kv_norm_g': gain(ks[9], (DEPTH, MLA_KV_RANK)),
        'mla_w_ukv': w(ks[10], (DEPTH, MLA_KV_RANK, MLA_HEADS * (MLA_NOPE + MLA_V)), MLA_KV_RANK),
        'mla_out_norm_g': gain(ks[11], (DEPTH, MLA_WIDTH)),
        'w_o': w(ks[12], (DEPTH, MIX_WIDTH, D_MODEL), MIX_WIDTH),
        'ffn_norm_g': gain(ks[13], (DEPTH, D_MODEL)),
        'w_gate': w(ks[14], (DEPTH, D_MODEL, D_FF), D_MODEL),
        'w_up': w(ks[15], (DEPTH, D_MODEL, D_FF), D_MODEL),
        'w_down': w(ks[16], (DEPTH, D_FF, D_MODEL), D_FF),
        'final_norm_g': gain(ks[17], (D_MODEL,)),
    }


def reference(x, positions, attn_norm_g, w_in, hg_lower_bounds, hg_norm_g, sb_norm_g,
              mla_q_norm_g, mla_w_uq, mla_kv_norm_g, mla_w_ukv, mla_out_norm_g, w_o,
              ffn_norm_g, w_gate, w_up, w_down, final_norm_g):
    b, s, _ = x.shape
    sm = jax.nn.softmax(hg_lower_bounds.astype(jnp.float32), axis=0)
    lower_bounds = jnp.cumsum(sm, axis=0) - sm[0:1]
    split_at = np.cumsum(IN_SIZES)[:-1].tolist()
    for layer in range(DEPTH):
        h = rmsnorm(x, attn_norm_g[layer])
        hq, hf, hi, hg, sq, sk, sv, c_q, c_kv_rope = jnp.split(h @ w_in[layer], split_at, axis=-1)

        hg_out = hgrn2_mixer(hq, hf, hi, lower_bounds[layer])
        hg_out = group_rmsnorm(hg_out, hg_norm_g[layer], HG_HEADS) * jax.nn.silu(hg)

        sb_out = stick_breaking_mixer(sq.reshape(b, s, SB_HEADS, SB_DH), sk.reshape(b, s, SB_HEADS, SB_DH),
                                      sv.reshape(b, s, SB_HEADS, SB_DH))
        sb_out = group_rmsnorm(sb_out, sb_norm_g[layer], SB_HEADS)

        mla_out = mla_mixer(c_q, c_kv_rope, positions, mla_q_norm_g[layer], mla_w_uq[layer],
                            mla_kv_norm_g[layer], mla_w_ukv[layer])
        mla_out = group_rmsnorm(mla_out, mla_out_norm_g[layer], MLA_HEADS)

        x = x + jnp.concatenate([hg_out, sb_out, mla_out], axis=-1) @ w_o[layer]

        h = rmsnorm(x, ffn_norm_g[layer])
        x = x + (jax.nn.silu(h @ w_gate[layer]) * (h @ w_up[layer])) @ w_down[layer]
    return rmsnorm(x, final_norm_g)
```

```cpp
#include <hip/hip_runtime.h>
#include <hip/hip_cooperative_groups.h>
#include <cstdio>
namespace cg = cooperative_groups;

#define LAS __attribute__((address_space(3)))
typedef unsigned short bf16_t;
typedef short bf16x8 __attribute__((ext_vector_type(8)));
typedef short s16x4 __attribute__((ext_vector_type(4)));
typedef float f32x4 __attribute__((ext_vector_type(4)));
typedef float f32x2 __attribute__((ext_vector_type(2)));
typedef float f32x16 __attribute__((ext_vector_type(16)));
typedef unsigned u32x4 __attribute__((ext_vector_type(4)));
typedef unsigned u32x2 __attribute__((ext_vector_type(2)));
typedef __bf16 bf16x2n __attribute__((ext_vector_type(2)));
#define DI __device__ __forceinline__
#define MFMA32(a, b, c) __builtin_amdgcn_mfma_f32_32x32x16_bf16((a), (b), (c), 0, 0, 0)

constexpr int M = 16384, DM = 2048, SEQ = 2048, NB = 8;
constexpr int NIN = 5184, NINP = 5376, DFF = 5632;
constexpr int C_HQ = 0, C_HF = 512, C_HV = 1024, C_HG = 1536, C_SQ = 2048, C_SK = 2816, C_SV = 3584, C_CQ = 4352, C_CKV = 4864, C_KR = 5120;
constexpr int NQ = 1152, NQP = 1280, NKV = 1536;
constexpr float EPS = 1e-6f;
constexpr float LOG2E = 1.4426950408889634f, LN2 = 0.6931471805599453f;

constexpr size_t MiB = 1u << 20;
constexpr size_t WS_CTL = 0;
constexpr size_t WS_WL = 1 * MiB;
constexpr size_t WL_IN = 0, WL_UQ = 21 * MiB, WL_UKV = WL_UQ + 1310720, WL_O = 23 * MiB, WL_SIZE = 31 * MiB;
constexpr size_t WS_WGU = 63 * MiB, WS_WDN = 107 * MiB;
constexpr size_t WS_XB = 129 * MiB;
constexpr size_t WS_BIG = 193 * MiB;
constexpr size_t WS_MIX = 369 * MiB;
constexpr size_t WS_KV = 433 * MiB;
constexpr size_t WS_END = 481 * MiB;
enum { SSQ_IN0 = 0, SSQ_IN1, SSQ_Q0, SSQ_Q1, SSQ_KV0, SSQ_KV1, SSQ_F0, SSQ_F1, SSQ_FIN, SSQ_N };
constexpr size_t CTL_QCTR = 15 * 65536;

constexpr int LDS_BYTES = 139264;
constexpr int LDS_QWORD = 136704;

DI int lane_id() { int l; asm volatile("v_mbcnt_lo_u32_b32 %0, -1, 0\n\tv_mbcnt_hi_u32_b32 %0, -1, %0" : "=v"(l)); return l; }
DI unsigned pk2(float a, float b) { f32x2 v = {a, b}; bf16x2n r = __builtin_convertvector(v, bf16x2n); return __builtin_bit_cast(unsigned, r); }
DI float bf2f(unsigned short u) { return __uint_as_float(((unsigned)u) << 16); }
DI float bflo(unsigned w) { return __uint_as_float(w << 16); }
DI float bfhi(unsigned w) { return __uint_as_float(w & 0xffff0000u); }
DI float fexp2(float x) { return __builtin_amdgcn_exp2f(x); }
DI float flog2(float x) { return __builtin_amdgcn_logf(x); }
DI float pair_sum(float v) { auto rr = __builtin_amdgcn_permlane32_swap(__float_as_uint(v), __float_as_uint(v), false, false); return __uint_as_float(rr[0]) + __uint_as_float(rr[1]); }
DI float pair_max(float v) { auto rr = __builtin_amdgcn_permlane32_swap(__float_as_uint(v), __float_as_uint(v), false, false); return fmaxf(__uint_as_float(rr[0]), __uint_as_float(rr[1])); }

namespace pg8 {
constexpr int BM = 256, BK = 64, HALF = 128, HTB = HALF * BK * 2, STAGE_BYTES = 8 * HTB, NXCD = 8, WGM = 8;
DI int lds_byte(int r, int c) { const int st = (r >> 4) * 2 + (c >> 5), rr = r & 15, cc = c & 31, ob = rr * 64 + cc * 2; return st * 1024 + (ob ^ (((ob >> 9) & 1) << 5)); }
DI void stage_rc(int b, int& R, int& C) { const int st = b / 1024, sb = b % 1024, swz = sb ^ (((sb >> 9) & 1) << 5); R = (st >> 1) * 16 + swz / 64; C = (st & 1) * 32 + (swz % 64) / 2; }
DI int perm32(int rho) { const int n = rho >> 4, i = rho & 15; return 8 * (i >> 2) + 4 * n + (i & 3); }
struct Unit { int pm, pn; };
struct Gemm { const bf16_t* A; const bf16_t* Bt; int M, N, K, lda; };
struct StaticOrder {
    int nM, nN, nwg, G, c;
    DI void init(int M_, int N_, int G_, int c_) { nM = M_ / BM; nN = N_ / BM; nwg = nM * nN; G = G_; c = c_; }
    DI bool next(int i, Unit& u) const {
        const long L = (long)i * G + c; if (L >= nwg) return false;
        int wgid = (int)L; { const int q = nwg / NXCD, r = nwg % NXCD, xcd = wgid % NXCD, off = wgid / NXCD; wgid = (xcd < r ? xcd * (q + 1) : r * (q + 1) + (xcd - r) * q) + off; }
        const int nig = WGM * nN, gid = wgid / nig, fm = gid * WGM, gsz = (nM - fm) < WGM ? (nM - fm) : WGM;
        u.pm = fm + ((wgid % nig) % gsz); u.pn = (wgid % nig) / gsz; return true;
    }
};
template <class Epi>
DI void gemm_phase(LAS unsigned char* lds, const Gemm g, const StaticOrder& S, const Epi& E, int wid) {
    int lane = lane_id(); asm volatile("" : "+v"(lane));
    const int tid = wid * 64 + lane, wr = wid >> 2, wc = wid & 3, fr = lane & 15, fq = lane >> 4;
    const int K = g.K, nt = K / BK, lda = g.lda;
    unsigned voffA[2], voffB[2];
#pragma unroll
    for (int i = 0; i < 2; ++i) { int R, C; stage_rc(tid * 16 + i * 8192, R, C); const int Rb = (R & ~31) + perm32(R & 31);
        voffA[i] = (unsigned)(R * lda + C) * 2u; voffB[i] = (unsigned)(Rb * K + C) * 2u; }
    const size_t kstep = (size_t)(BK * 2);
    const size_t hstepA = (size_t)HALF * lda * 2, hstepB = (size_t)HALF * K * 2;
    const size_t tstepA = 2 * hstepA, tstepB = 2 * hstepB;
    const unsigned ldsw = (unsigned)wid * 1024u;
    const int aoff = lds_byte(wr * 64 + fr, fq * 8), boff = lds_byte(wc * 32 + fr, fq * 8);
#define PG8_SA(b, h) (((b) * 2 + (h)) * HTB)
#define PG8_SB(b, h) ((4 + (b) * 2 + (h)) * HTB)
#define PG8_STAGE(bufoff, gbase, voff) do { _Pragma("unroll") for (int _i = 0; _i < 2; ++_i) \
        __builtin_amdgcn_global_load_lds((const unsigned*)((const char*)(gbase) + (voff)[_i]), (LAS unsigned*)(lds + (bufoff) + ldsw + _i * 8192), 16, 0, 0); } while (0)
#define PG8_LDA(dst, b, h) do { _Pragma("unroll") for (int m = 0; m < 4; ++m) _Pragma("unroll") for (int k = 0; k < 2; ++k) dst[m][k] = *(const LAS bf16x8*)(lds + PG8_SA(b, h) + aoff + m * 2048 + k * 1024); } while (0)
#define PG8_LDB(dst, b, h) do { _Pragma("unroll") for (int n = 0; n < 2; ++n) _Pragma("unroll") for (int k = 0; k < 2; ++k) dst[n][k] = *(const LAS bf16x8*)(lds + PG8_SB(b, h) + boff + n * 2048 + k * 1024); } while (0)
#define PG8_MMA(ai, bj, At, Bt) do { __builtin_amdgcn_s_setprio(1); _Pragma("unroll") for (int m = 0; m < 4; ++m) _Pragma("unroll") for (int n = 0; n < 2; ++n) _Pragma("unroll") for (int k = 0; k < 2; ++k) \
        acc[ai][bj][m][n] = __builtin_amdgcn_mfma_f32_16x16x32_bf16(Bt[n][k], At[m][k], acc[ai][bj][m][n], 0, 0, 0); __builtin_amdgcn_s_setprio(0); } while (0)
#define PG8_WAIT_V(n) asm volatile("s_waitcnt vmcnt(" #n ")" ::: "memory")
#define PG8_WAIT_L(n) asm volatile("s_waitcnt lgkmcnt(" #n ")" ::: "memory")
#define PG8_BAR __builtin_amdgcn_s_barrier()
#define PG8_SCHED __builtin_amdgcn_sched_barrier(0)
    Unit cur, nxt; int ui = 0;
    if (!S.next(0, cur)) return;
    f32x4 acc[2][2][4][2];
#pragma unroll
    for (int a = 0; a < 2; ++a)
#pragma unroll
        for (int b = 0; b < 2; ++b)
#pragma unroll
            for (int m = 0; m < 4; ++m)
#pragma unroll
                for (int n = 0; n < 2; ++n) acc[a][b][m][n] = (f32x4){0.f, 0.f, 0.f, 0.f};
    bf16x8 At[4][2], B0[2][2], B1[2][2];
    const char* cA = (const char*)g.A + (size_t)cur.pm * tstepA; const char* cB = (const char*)g.Bt + (size_t)cur.pn * tstepB;
    PG8_STAGE(PG8_SB(0, 0), cB, voffB); PG8_STAGE(PG8_SA(0, 0), cA, voffA); PG8_STAGE(PG8_SB(0, 1), cB + hstepB, voffB); PG8_STAGE(PG8_SA(0, 1), cA + hstepA, voffA);
    if (wr == 1) PG8_BAR;
    PG8_WAIT_V(4); PG8_BAR;
    PG8_STAGE(PG8_SB(1, 0), cB + kstep, voffB); PG8_STAGE(PG8_SA(1, 0), cA + kstep, voffA); PG8_STAGE(PG8_SB(1, 1), cB + hstepB + kstep, voffB);
    PG8_WAIT_V(6); PG8_BAR;
    for (;;) {
        const bool has_next = S.next(ui + 1, nxt);
        const char* nA = has_next ? (const char*)g.A + (size_t)nxt.pm * tstepA : cA; const char* nB = has_next ? (const char*)g.Bt + (size_t)nxt.pn * tstepB : cB;
        for (int t = 0; t < nt; t += 2) {
            const bool last = (t == nt - 2);
            const char* a1 = cA + (size_t)(t + 1) * kstep;
            const char* a2 = last ? nA : cA + (size_t)(t + 2) * kstep; const char* b2 = last ? nB : cB + (size_t)(t + 2) * kstep;
            const char* a3 = a2 + kstep; const char* b3 = b2 + kstep;
            PG8_LDB(B0, 0, 0); PG8_SCHED; PG8_LDA(At, 0, 0); PG8_STAGE(PG8_SA(1, 1), a1 + hstepA, voffA);
            PG8_WAIT_L(8); PG8_BAR; PG8_WAIT_L(0); PG8_MMA(0, 0, At, B0); PG8_BAR; PG8_SCHED;
            PG8_LDB(B1, 0, 1); PG8_STAGE(PG8_SB(0, 0), b2, voffB);
            PG8_BAR; PG8_WAIT_L(0); PG8_MMA(0, 1, At, B1); PG8_BAR;
            PG8_LDA(At, 0, 1); PG8_STAGE(PG8_SA(0, 0), a2, voffA);
            PG8_BAR; PG8_WAIT_L(0); PG8_MMA(1, 0, At, B0); PG8_BAR; PG8_SCHED;
            PG8_STAGE(PG8_SB(0, 1), b2 + hstepB, voffB);
            PG8_WAIT_V(6); PG8_BAR; PG8_MMA(1, 1, At, B1); PG8_BAR;
            PG8_LDB(B0, 1, 0); PG8_SCHED; PG8_LDA(At, 1, 0); PG8_STAGE(PG8_SA(0, 1), a2 + hstepA, voffA);
            PG8_WAIT_L(8); PG8_BAR; PG8_WAIT_L(0); PG8_MMA(0, 0, At, B0); PG8_BAR; PG8_SCHED;
            PG8_LDB(B1, 1, 1); PG8_STAGE(PG8_SB(1, 0), b3, voffB);
            PG8_BAR; PG8_WAIT_L(0); PG8_MMA(0, 1, At, B1); PG8_BAR;
            PG8_LDA(At, 1, 1); PG8_STAGE(PG8_SA(1, 0), a3, voffA);
            PG8_BAR; PG8_WAIT_L(0); PG8_MMA(1, 0, At, B0); PG8_BAR; PG8_SCHED;
            PG8_STAGE(PG8_SB(1, 1), b3 + hstepB, voffB);
            PG8_WAIT_V(6); PG8_BAR; PG8_MMA(1, 1, At, B1); PG8_BAR;
        }
        E(acc, cur, wr, wc, fr, fq);
        if (!has_next) break;
#pragma unroll
        for (int a = 0; a < 2; ++a)
#pragma unroll
            for (int b = 0; b < 2; ++b)
#pragma unroll
                for (int m = 0; m < 4; ++m)
#pragma unroll
                    for (int n = 0; n < 2; ++n) acc[a][b][m][n] = (f32x4){0.f, 0.f, 0.f, 0.f};
        cur = nxt; cA = nA; cB = nB; ++ui;
    }
    PG8_WAIT_V(0);
    if (wr == 0) PG8_BAR;
    PG8_BAR;
#undef PG8_SA
#undef PG8_SB
#undef PG8_STAGE
#undef PG8_LDA
#undef PG8_LDB
#undef PG8_MMA
#undef PG8_WAIT_V
#undef PG8_WAIT_L
#undef PG8_BAR
#undef PG8_SCHED
}
}

typedef f32x4 AccT[2][2][4][2];

DI void rope8(f32x4& v0, f32x4& v1, int pos, int i0) {
    const float fp = (float)pos;
    float x[8] = {v0[0], v0[1], v0[2], v0[3], v1[0], v1[1], v1[2], v1[3]};
#pragma unroll
    for (int p = 0; p < 4; ++p) {
        const float invf = fexp2(-(float)(i0 + p) * 0.41524101186092029f);
        const float rev = __builtin_amdgcn_fractf(fp * invf * 0.15915494309189535f);
        const float sn = __builtin_amdgcn_sinf(rev), cs = __builtin_amdgcn_cosf(rev);
        const float x1 = x[2 * p], x2 = x[2 * p + 1];
        x[2 * p] = x1 * cs - x2 * sn; x[2 * p + 1] = x2 * cs + x1 * sn;
    }
    v0 = (f32x4){x[0], x[1], x[2], x[3]}; v1 = (f32x4){x[4], x[5], x[6], x[7]};
}
DI float quad_sum(float s) {
    auto r = __builtin_amdgcn_permlane16_swap(__float_as_uint(s), __float_as_uint(s), false, false);
    s = __uint_as_float(r[0]) + __uint_as_float(r[1]);
    return pair_sum(s);
}
#define DPP_ADD(s, ctrl) (s) += __uint_as_float((unsigned)__builtin_amdgcn_update_dpp(0, (int)__float_as_uint(s), (ctrl), 0xf, 0xf, true))
DI float wave_sum64(float s) {
    DPP_ADD(s, 0xB1); DPP_ADD(s, 0x4E);
    DPP_ADD(s, 0x141); DPP_ADD(s, 0x140);
    return quad_sum(s);
}

struct EpiIn {
    bf16_t* P; const float* ssq_in; float* ssq_q; float* ssq_kv; const int* pos;
    DI void operator()(const AccT& acc, const pg8::Unit& u, int wr, int wc, int fr, int fq) const {
        const int row0 = u.pm * 256 + wr * 64 + fr, col0 = u.pn * 256 + wc * 32 + 8 * fq;
        const bool do_rope = (u.pn == 20) && (wc < 2);
        float* ssq = (u.pn == 17 || u.pn == 18) ? ssq_q : (u.pn == 19 ? ssq_kv : nullptr);
#pragma unroll
        for (int ai = 0; ai < 2; ++ai)
#pragma unroll
            for (int m = 0; m < 4; ++m) {
                const int row = row0 + ai * 128 + m * 16;
                const float sc = rsqrtf(ssq_in[row] * (1.0f / DM) + EPS);
                float s = 0.f;
#pragma unroll
                for (int bj = 0; bj < 2; ++bj) {
                    f32x4 v0 = acc[ai][bj][m][0] * sc, v1 = acc[ai][bj][m][1] * sc;
                    if (do_rope && bj == 0) rope8(v0, v1, pos[row], 16 * wc + 4 * fq);
                    s += (v0[0] * v0[0] + v0[1] * v0[1]) + (v0[2] * v0[2] + v0[3] * v0[3]) + (v1[0] * v1[0] + v1[1] * v1[1]) + (v1[2] * v1[2] + v1[3] * v1[3]);
                    u32x4 w; w.x = pk2(v0[0], v0[1]); w.y = pk2(v0[2], v0[3]); w.z = pk2(v1[0], v1[1]); w.w = pk2(v1[2], v1[3]);
                    *(u32x4*)(P + (size_t)row * NINP + col0 + bj * 128) = w;
                }
                if (ssq) { s = quad_sum(s); if (fq == 0) atomicAdd(ssq + row, s); }
                asm volatile("" ::: "memory");
            }
    }
};
struct EpiQ {
    bf16_t* Q; const float* ssq_q; const int* pos;
    DI void operator()(const AccT& acc, const pg8::Unit& u, int wr, int wc, int fr, int fq) const {
        const int row0 = u.pm * 256 + wr * 64 + fr, col0 = u.pn * 256 + wc * 32 + 8 * fq;
#pragma unroll
        for (int ai = 0; ai < 2; ++ai)
#pragma unroll
            for (int m = 0; m < 4; ++m) {
                const int row = row0 + ai * 128 + m * 16;
                const float sc = rsqrtf(ssq_q[row] * (1.0f / 512.0f) + EPS);
                const int ps = pos[row];
#pragma unroll
                for (int bj = 0; bj < 2; ++bj) {
                    const int c = col0 + bj * 128;
                    if (c < NQ) {
                        f32x4 v0 = acc[ai][bj][m][0] * sc, v1 = acc[ai][bj][m][1] * sc;
                        const int within = c % 192;
                        if (within >= 128) rope8(v0, v1, ps, (within - 128) >> 1);
                        u32x4 w; w.x = pk2(v0[0], v0[1]); w.y = pk2(v0[2], v0[3]); w.z = pk2(v1[0], v1[1]); w.w = pk2(v1[2], v1[3]);
                        *(u32x4*)(Q + (size_t)row * NQ + c) = w;
                    }
                }
                asm volatile("" ::: "memory");
            }
    }
};
struct EpiKV {
    bf16_t* KV; const float* ssq_kv;
    DI void operator()(const AccT& acc, const pg8::Unit& u, int wr, int wc, int fr, int fq) const {
        const int row0 = u.pm * 256 + wr * 64 + fr, col0 = u.pn * 256 + wc * 32 + 8 * fq;
#pragma unroll
        for (int ai = 0; ai < 2; ++ai)
#pragma unroll
            for (int m = 0; m < 4; ++m) {
                const int row = row0 + ai * 128 + m * 16;
                const float sc = rsqrtf(ssq_kv[row] * (1.0f / 256.0f) + EPS);
#pragma unroll
                for (int bj = 0; bj < 2; ++bj) {
                    const f32x4 v0 = acc[ai][bj][m][0] * sc, v1 = acc[ai][bj][m][1] * sc;
                    u32x4 w; w.x = pk2(v0[0], v0[1]); w.y = pk2(v0[2], v0[3]); w.z = pk2(v1[0], v1[1]); w.w = pk2(v1[2], v1[3]);
                    *(u32x4*)(KV + (size_t)row * NKV + col0 + bj * 128) = w;
                }
                asm volatile("" ::: "memory");
            }
    }
};
struct EpiRes {
    const float* xin; float* xout; bf16_t* XB; float* ssq_out;
    DI void operator()(const AccT& acc, const pg8::Unit& u, int wr, int wc, int fr, int fq) const {
        const int row0 = u.pm * 256 + wr * 64 + fr, col0 = u.pn * 256 + wc * 32 + 8 * fq;
#pragma unroll
        for (int ai = 0; ai < 2; ++ai)
#pragma unroll
            for (int m = 0; m < 4; ++m) {
                const int row = row0 + ai * 128 + m * 16;
                float s = 0.f;
#pragma unroll
                for (int bj = 0; bj < 2; ++bj) {
                    const size_t off = (size_t)row * DM + col0 + bj * 128;
                    const f32x4 v0 = acc[ai][bj][m][0] + *(const f32x4*)(xin + off), v1 = acc[ai][bj][m][1] + *(const f32x4*)(xin + off + 4);
                    *(f32x4*)(xout + off) = v0; *(f32x4*)(xout + off + 4) = v1;
                    s += (v0[0] * v0[0] + v0[1] * v0[1]) + (v0[2] * v0[2] + v0[3] * v0[3]) + (v1[0] * v1[0] + v1[1] * v1[1]) + (v1[2] * v1[2] + v1[3] * v1[3]);
                    u32x4 w; w.x = pk2(v0[0], v0[1]); w.y = pk2(v0[2], v0[3]); w.z = pk2(v1[0], v1[1]); w.w = pk2(v1[2], v1[3]);
                    *(u32x4*)(XB + off) = w;
                }
                s = quad_sum(s); if (fq == 0) atomicAdd(ssq_out + row, s);
                asm volatile("" ::: "memory");
            }
    }
};
struct EpiGU {
    bf16_t* H; const float* ssq_f;
    DI void operator()(const AccT& acc, const pg8::Unit& u, int wr, int wc, int fr, int fq) const {
        const int row0 = u.pm * 256 + wr * 64 + fr, col0 = u.pn * 128 + wc * 32 + 8 * fq;
#pragma unroll
        for (int ai = 0; ai < 2; ++ai)
#pragma unroll
            for (int m = 0; m < 4; ++m) {
                const int row = row0 + ai * 128 + m * 16;
                const float sc = rsqrtf(ssq_f[row] * (1.0f / DM) + EPS);
                float hv[8];
#pragma unroll
                for (int n = 0; n < 2; ++n)
#pragma unroll
                    for (int j = 0; j < 4; ++j) { const float gt = acc[ai][0][m][n][j] * sc, up = acc[ai][1][m][n][j] * sc;
                        hv[n * 4 + j] = gt * __builtin_amdgcn_rcpf(1.0f + fexp2(-gt * LOG2E)) * up; }
                u32x4 w; w.x = pk2(hv[0], hv[1]); w.y = pk2(hv[2], hv[3]); w.z = pk2(hv[4], hv[5]); w.w = pk2(hv[6], hv[7]);
                *(u32x4*)(H + (size_t)row * DFF + col0) = w;
                asm volatile("" ::: "memory");
            }
    }
};

struct WJob { const float* W; const float* W2; int ldw, K, nrows, mode; const float* g1; const float* g2; const float* g3; int b1, b2; bf16_t* WT; };
DI void wjob_item(const WJob& J, int item, LAS float* scr, int lane) {
    const int nblk = J.nrows / 32, kb = item / nblk, nb = item % nblk, k0 = 64 * kb, n0 = 32 * nb;
    const int n = n0 + (lane & 31);
    int col = -1; const float* Wp = J.W;
    if (J.mode == 0) { if (n < J.ldw) col = n; }
    else if (J.mode == 1) { if (n < C_KR) col = n; else if (n < NIN) { const int j = n - C_KR; col = C_KR + (j >> 1) + 32 * (j & 1); } }
    else if (J.mode == 2) { if (n < NQ) { const int hd = n / 192, w = n % 192; if (w < 128) col = n; else { const int j = w - 128; col = hd * 192 + 128 + (j >> 1) + 32 * (j & 1); } } }
    else { const int tile = n >> 8, w = n & 255; col = tile * 128 + (w & 127); if (w >= 128) Wp = J.W2; }
    const bool has_gain = (J.g1 != nullptr);
    const float* gp = J.g1 + k0; if (k0 >= J.b2) gp = J.g3 + (k0 - J.b2); else if (k0 >= J.b1) gp = J.g2 + (k0 - J.b1);
#pragma unroll 8
    for (int i = 0; i < 32; ++i) {
        const int kk = 2 * i + (lane >> 5), k = k0 + kk;
        float v = 0.f;
        if (col >= 0) {
            v = Wp[(size_t)k * J.ldw + col];
            if (has_gain) v *= gp[kk];
        }
        scr[kk * 33 + (lane & 31)] = v;
    }
    asm volatile("s_waitcnt lgkmcnt(0)" ::: "memory");
    const int c = lane & 7;
#pragma unroll
    for (int j = 0; j < 4; ++j) { const int nn = (lane >> 3) + 8 * j; const LAS float* s = scr + (8 * c) * 33 + nn;
        u32x4 o; o.x = pk2(s[0 * 33], s[1 * 33]); o.y = pk2(s[2 * 33], s[3 * 33]); o.z = pk2(s[4 * 33], s[5 * 33]); o.w = pk2(s[6 * 33], s[7 * 33]);
        *(u32x4*)(J.WT + (size_t)(n0 + nn) * J.K + k0 + 8 * c) = o; }
    asm volatile("s_waitcnt lgkmcnt(0)" ::: "memory");
}
DI void run_wjob(const WJob& J, LAS unsigned char* lds, int gw, int NGW, int lane, int wave) {
    LAS float* scr = (LAS float*)(lds + wave * 16384);
    const int nitems = (J.K / 64) * (J.nrows / 32);
    asm volatile("" : "+s"(NGW));
    for (int it = gw; it < nitems; it += NGW) wjob_item(J, it, scr, lane);
}

DI int crow(int i, int hh) { return (i & 3) + 8 * (i >> 2) + 4 * hh; }
DI bf16x8 pack8(const f32x16& x, int s) {
    u32x4 p = {pk2(x[8 * s], x[8 * s + 1]), pk2(x[8 * s + 2], x[8 * s + 3]), pk2(x[8 * s + 4], x[8 * s + 5]), pk2(x[8 * s + 6], x[8 * s + 7])};
    return __builtin_bit_cast(bf16x8, p);
}
DI bf16x8 tr_pair(LAS unsigned char* p_lo) {
    const s16x4 lo = __builtin_amdgcn_ds_read_tr16_b64_v4i16((LAS s16x4*)p_lo);
    const s16x4 hi = __builtin_amdgcn_ds_read_tr16_b64_v4i16((LAS s16x4*)(p_lo + 8 * 320));
    return __builtin_shufflevector(lo, hi, 0, 1, 2, 3, 4, 5, 6, 7);
}
constexpr int VPITCH = 320;

DI void pv_step(f32x16 (&o)[4], LAS unsigned char* Vs, const bf16x8& pb, int hf, int ks2, int lane) {
    const int i16 = lane & 15, q = i16 >> 2, p = i16 & 3, blk = (lane >> 4) & 1, hh = lane >> 5;
    LAS unsigned char* base = Vs + (32 * hf + 16 * ks2 + 4 * hh + q) * VPITCH + 32 * blk + 8 * p;
#pragma unroll
    for (int db = 0; db < 4; ++db) { const bf16x8 a = tr_pair(base + db * 64); o[db] = MFMA32(a, pb, o[db]); }
}
DI void out_norm_store(f32x16 (&o)[4], float pre, bf16_t* dst_row, int hh) {
    float ss = 0.f;
#pragma unroll
    for (int db = 0; db < 4; ++db)
#pragma unroll
        for (int i = 0; i < 16; ++i) { o[db][i] *= pre; ss += o[db][i] * o[db][i]; }
    ss = pair_sum(ss);
    const float rs = rsqrtf(ss * (1.0f / 128.0f) + EPS);
#pragma unroll
    for (int db = 0; db < 4; ++db)
#pragma unroll
        for (int g = 0; g < 4; ++g) {
            u32x2 w; w.x = pk2(o[db][4 * g] * rs, o[db][4 * g + 1] * rs); w.y = pk2(o[db][4 * g + 2] * rs, o[db][4 * g + 3] * rs);
            *(u32x2*)(dst_row + 32 * db + 8 * g + 4 * hh) = w;
        }
}

DI void sb_item(LAS unsigned char* lds, const bf16_t* P, bf16_t* MIX, int b, int h, int qb, int wave_) {
    const int tid = wave_ * 64 + lane_id();
    const int lane = tid & 63, wave = wave_, r = lane & 31, hh = lane >> 5;
    const size_t tok0 = (size_t)b * SEQ;
    const int tq0 = qb * 256 + wave * 32;
    constexpr int KP = 272;
    LAS unsigned char* Ks = lds; LAS unsigned char* Vs = lds + 64 * KP;
    bf16x8 qf[8];
    { const bf16_t* qp = P + (tok0 + tq0 + r) * NINP + C_SQ + h * 128 + hh * 8;
#pragma unroll
      for (int ks = 0; ks < 8; ++ks) qf[ks] = *(const bf16x8*)(qp + ks * 16); }
    f32x16 o[4];
#pragma unroll
    for (int db = 0; db < 4; ++db)
#pragma unroll
        for (int i = 0; i < 16; ++i) o[db][i] = 0.f;
    float carry = 0.f;
    const int ntiles = 4 * qb + 4;
    const float scale = 0.08838834764831845f;
    u32x4 kreg[2], vreg[2];
    const bf16_t* kbase = P + tok0 * NINP + C_SK + h * 128;
    const bf16_t* vbase = P + tok0 * NINP + C_SV + h * 128;
#define SB_LOAD(kt) do { _Pragma("unroll") for (int i_ = 0; i_ < 2; ++i_) { const int c_ = tid + 512 * i_, row_ = c_ >> 4, col_ = c_ & 15; \
        const size_t go_ = (size_t)((kt) * 64 + row_) * NINP + col_ * 8; kreg[i_] = *(const u32x4*)(kbase + go_); vreg[i_] = *(const u32x4*)(vbase + go_); } } while (0)
#define SB_STORE() do { _Pragma("unroll") for (int i_ = 0; i_ < 2; ++i_) { const int c_ = tid + 512 * i_, row_ = c_ >> 4, col_ = c_ & 15; \
        *(LAS u32x4*)(Ks + row_ * KP + col_ * 16) = kreg[i_]; *(LAS u32x4*)(Vs + row_ * VPITCH + col_ * 16) = vreg[i_]; } } while (0)
    SB_LOAD(ntiles - 1);
    for (int kt = ntiles - 1; kt >= 0; --kt) {
        __syncthreads();
        SB_STORE();
        __syncthreads();
        if (kt > 0) SB_LOAD(kt - 1);
        if (kt * 64 <= tq0) {
            const int t = tq0 + r;
#pragma unroll
            for (int hf = 1; hf >= 0; --hf) {
                f32x16 acc;
#pragma unroll
                for (int i = 0; i < 16; ++i) acc[i] = 0.f;
#pragma unroll
                for (int ks = 0; ks < 8; ++ks) { const bf16x8 a = *(const LAS bf16x8*)(Ks + (32 * hf + r) * KP + (16 * ks + 8 * hh) * 2); acc = MFMA32(a, qf[ks], acc); }
                const int sbase = kt * 64 + 32 * hf + 4 * hh;
                float lk[16];
#pragma unroll
                for (int i = 0; i < 16; ++i) {
                    const float z = acc[i] * scale;
                    const bool valid = (sbase + (i & 3) + 8 * (i >> 2)) < t;
                    const float e = fexp2(-fabsf(z) * LOG2E);
                    const float sp = fmaxf(z, 0.f) + flog2(1.0f + e) * LN2;
                    lk[i] = valid ? -sp : 0.f;
                    acc[i] = z;
                }
                float G[4], PT[4], GP[4];
#pragma unroll
                for (int g = 0; g < 4; ++g) {
                    G[g] = (lk[4 * g] + lk[4 * g + 1]) + (lk[4 * g + 2] + lk[4 * g + 3]);
                    auto rr = __builtin_amdgcn_permlane32_swap(__float_as_uint(G[g]), __float_as_uint(G[g]), false, false);
                    const float lo = __uint_as_float(rr[0]), up = __uint_as_float(rr[1]);
                    PT[g] = lo + up; GP[g] = hh ? lo : up;
                }
                float running = carry;
#pragma unroll
                for (int g = 3; g >= 0; --g) {
                    const float off = running + (hh == 0 ? GP[g] : 0.f);
                    const float c3 = off + lk[4 * g + 3], c2 = c3 + lk[4 * g + 2], c1 = c2 + lk[4 * g + 1], c0 = c1 + lk[4 * g];
                    acc[4 * g + 3] = ((sbase + 3 + 8 * g) < t) ? fexp2((acc[4 * g + 3] + c3) * LOG2E) : 0.f;
                    acc[4 * g + 2] = ((sbase + 2 + 8 * g) < t) ? fexp2((acc[4 * g + 2] + c2) * LOG2E) : 0.f;
                    acc[4 * g + 1] = ((sbase + 1 + 8 * g) < t) ? fexp2((acc[4 * g + 1] + c1) * LOG2E) : 0.f;
                    acc[4 * g + 0] = ((sbase + 0 + 8 * g) < t) ? fexp2((acc[4 * g + 0] + c0) * LOG2E) : 0.f;
                    running += PT[g];
                }
                carry = running;
#pragma unroll
                for (int ks2 = 0; ks2 < 2; ++ks2) { const bf16x8 pb = pack8(acc, ks2); pv_step(o, Vs, pb, hf, ks2, lane); }
            }
        }
    }
#undef SB_LOAD
#undef SB_STORE
    out_norm_store(o, 1.0f, MIX + (tok0 + tq0 + r) * DM + 512 + h * 128, hh);
}

DI void mla_item(LAS unsigned char* lds, const bf16_t* P, const bf16_t* Q, const bf16_t* KV, bf16_t* MIX, int b, int h, int qb, int wave_) {
    const int tid = wave_ * 64 + lane_id();
    const int lane = tid & 63, wave = wave_, r = lane & 31, hh = lane >> 5;
    const size_t tok0 = (size_t)b * SEQ;
    const int tq0 = qb * 256 + wave * 32;
    constexpr int KP = 400;
    LAS unsigned char* Ks = lds; LAS unsigned char* Vs = lds + 64 * KP;
    bf16x8 qf[12];
    { const bf16_t* qp = Q + (tok0 + tq0 + r) * NQ + h * 192 + hh * 8;
#pragma unroll
      for (int ks = 0; ks < 12; ++ks) qf[ks] = *(const bf16x8*)(qp + ks * 16); }
    f32x16 o[4];
#pragma unroll
    for (int db = 0; db < 4; ++db)
#pragma unroll
        for (int i = 0; i < 16; ++i) o[db][i] = 0.f;
    float m_run = -1e30f, l_run = 0.f;
    const int ntiles = 4 * qb + 4;
    const float C = 0.07216878364870322f * LOG2E;
    u32x4 kreg[2], vreg[2], rreg;
    const bf16_t* kbase = KV + tok0 * NKV + h * 256;
    const bf16_t* rbase = P + tok0 * NINP + C_KR;
#define ML_LOAD(kt) do { _Pragma("unroll") for (int i_ = 0; i_ < 2; ++i_) { const int c_ = tid + 512 * i_, row_ = c_ >> 4, col_ = c_ & 15; \
        const size_t go_ = (size_t)((kt) * 64 + row_) * NKV + col_ * 8; kreg[i_] = *(const u32x4*)(kbase + go_); vreg[i_] = *(const u32x4*)(kbase + go_ + 128); } \
        rreg = *(const u32x4*)(rbase + (size_t)((kt) * 64 + (tid >> 3)) * NINP + (tid & 7) * 8); } while (0)
#define ML_STORE() do { _Pragma("unroll") for (int i_ = 0; i_ < 2; ++i_) { const int c_ = tid + 512 * i_, row_ = c_ >> 4, col_ = c_ & 15; \
        *(LAS u32x4*)(Ks + row_ * KP + col_ * 16) = kreg[i_]; *(LAS u32x4*)(Vs + row_ * VPITCH + col_ * 16) = vreg[i_]; } \
        *(LAS u32x4*)(Ks + (tid >> 3) * KP + 256 + (tid & 7) * 16) = rreg; } while (0)
    ML_LOAD(0);
    for (int kt = 0; kt < ntiles; ++kt) {
        __syncthreads();
        ML_STORE();
        __syncthreads();
        if (kt + 1 < ntiles) ML_LOAD(kt + 1);
        if (kt <= (tq0 >> 6)) {
            f32x16 s0, s1;
#pragma unroll
            for (int i = 0; i < 16; ++i) { s0[i] = 0.f; s1[i] = 0.f; }
#pragma unroll
            for (int ks = 0; ks < 12; ++ks) {
                const bf16x8 a0 = *(const LAS bf16x8*)(Ks + r * KP + (16 * ks + 8 * hh) * 2);
                const bf16x8 a1 = *(const LAS bf16x8*)(Ks + (32 + r) * KP + (16 * ks + 8 * hh) * 2);
                s0 = MFMA32(a0, qf[ks], s0); s1 = MFMA32(a1, qf[ks], s1);
            }
            float mx = s0[0];
#pragma unroll
            for (int i = 1; i < 16; ++i) mx = fmaxf(mx, s0[i]);
#pragma unroll
            for (int i = 0; i < 16; ++i) mx = fmaxf(mx, s1[i]);
            mx = pair_max(mx);
            const float mnew = fmaxf(m_run, mx);
            const float alpha = fexp2((m_run - mnew) * C);
            m_run = mnew;
            const float mc = -mnew * C;
            float ps = 0.f;
#pragma unroll
            for (int i = 0; i < 16; ++i) { s0[i] = fexp2(fmaf(s0[i], C, mc)); s1[i] = fexp2(fmaf(s1[i], C, mc)); ps += s0[i] + s1[i]; }
            ps = pair_sum(ps);
            l_run = l_run * alpha + ps;
#pragma unroll
            for (int db = 0; db < 4; ++db)
#pragma unroll
                for (int i = 0; i < 16; ++i) o[db][i] *= alpha;
#pragma unroll
            for (int ks2 = 0; ks2 < 2; ++ks2) { const bf16x8 pb = pack8(s0, ks2); pv_step(o, Vs, pb, 0, ks2, lane); }
#pragma unroll
            for (int ks2 = 0; ks2 < 2; ++ks2) { const bf16x8 pb = pack8(s1, ks2); pv_step(o, Vs, pb, 1, ks2, lane); }
        }
    }
#undef ML_LOAD
#undef ML_STORE
    out_norm_store(o, 1.0f / l_run, MIX + (tok0 + tq0 + r) * DM + 1280 + h * 128, hh);
}

DI void hg_item(LAS unsigned char* lds, const bf16_t* P, bf16_t* MIX, const float* lbs, int layer, int b, int h, int wave_) {
    const int tid = wave_ * 64 + lane_id();
    const int lane = tid & 63, wave = wave_, r = lane & 31, hh = lane >> 5;
    const int k = tid & 127, tq = tid >> 7;
    constexpr int P128 = 272, P64 = 144;
    LAS unsigned char* Qt = lds; LAS unsigned char* Kt = lds + 17408; LAS unsigned char* Qg = lds + 34816;
    LAS unsigned char* KgT = lds + 52224; LAS unsigned char* VT = lds + 70656; LAS unsigned char* Am = lds + 89088; LAS unsigned char* ST = lds + 98304;
    LAS float* tot = (LAS float*)(lds + 133120); LAS float* dec = (LAS float*)(lds + 135168); LAS float* red = (LAS float*)(lds + 135680);
    float lb = 0.f;
    if (layer == 1) { const float a0 = lbs[h * 128 + k], a1 = lbs[512 + h * 128 + k]; lb = 1.0f / (1.0f + __expf(a0 - a1)); }
    const float oml = 1.0f - lb;
    const size_t tok0 = (size_t)b * SEQ;
    __syncthreads();
    for (int i = tid; i < 34816 / 4; i += 512) ((LAS unsigned*)ST)[i] = 0u;
    f32x16 st[2];
#pragma unroll
    for (int j = 0; j < 2; ++j)
#pragma unroll
        for (int i = 0; i < 16; ++i) st[j][i] = 0.f;
    unsigned rqf[16]; u32x4 vld[2];
    const bf16_t* qbase = P + tok0 * NINP + C_HQ + h * 128 + k;
    const bf16_t* vbase = P + tok0 * NINP + C_HV + h * 128;
#define HG_LOAD(c) do { _Pragma("unroll") for (int i_ = 0; i_ < 16; ++i_) { const size_t go_ = (size_t)((c) * 64 + 16 * tq + i_) * NINP; rqf[i_] = (unsigned)qbase[go_] | ((unsigned)qbase[go_ + 512] << 16); } \
        _Pragma("unroll") for (int i_ = 0; i_ < 2; ++i_) { const int c_ = tid + 512 * i_, s_ = c_ & 63, v0_ = (c_ >> 6) * 8; vld[i_] = *(const u32x4*)(vbase + (size_t)((c) * 64 + s_) * NINP + v0_); } } while (0)
    HG_LOAD(0);
    for (int c = 0; c < 32; ++c) {
        float lf[16], kk[16]; float cs = 0.f;
#pragma unroll
        for (int i = 0; i < 16; ++i) {
            const float fp = bfhi(rqf[i]);
            const float e = fexp2(-fp * LOG2E);
            const float sg = __builtin_amdgcn_rcpf(1.0f + e);
            const float sn = (e > 1e30f) ? 1.0f : e * sg;
            const float f = lb + oml * sg;
            cs += flog2(fmaxf(f, 1e-37f)) * LN2; lf[i] = cs; kk[i] = oml * sn;
        }
        tot[tq * 128 + k] = cs;
        __syncthreads();
        const float t0 = tot[k], t1 = tot[128 + k], t2 = tot[256 + k], t3 = tot[384 + k];
        const float offs = (tq > 0 ? t0 : 0.f) + (tq > 1 ? t1 : 0.f) + (tq > 2 ? t2 : 0.f);
        const float gref = t0 + t1, gl = (t0 + t1) + (t2 + t3);
#pragma unroll
        for (int i = 0; i < 16; ++i) {
            const float g = offs + lf[i]; const int t = 16 * tq + i; const float qv = bflo(rqf[i]);
            const float e1 = fexp2(fminf(g - gref, 80.f) * LOG2E), e2 = fexp2(g * LOG2E), e3 = fexp2(fminf(gref - g, 80.f) * LOG2E), e4 = fexp2((gl - g) * LOG2E);
            *(LAS unsigned short*)(Qt + t * P128 + k * 2) = (unsigned short)pk2(qv * e1, 0.f);
            *(LAS unsigned short*)(Qg + t * P128 + k * 2) = (unsigned short)pk2(qv * e2, 0.f);
            *(LAS unsigned short*)(Kt + t * P128 + k * 2) = (unsigned short)pk2(kk[i] * e3, 0.f);
            *(LAS unsigned short*)(KgT + k * P64 + t * 2) = (unsigned short)pk2(kk[i] * e4, 0.f);
        }
        if (tq == 0) dec[k] = fexp2(gl * LOG2E);
#pragma unroll
        for (int i = 0; i < 2; ++i) { const int c_ = tid + 512 * i, s_ = c_ & 63, v0_ = (c_ >> 6) * 8;
            const unsigned w[4] = {vld[i].x, vld[i].y, vld[i].z, vld[i].w};
#pragma unroll
            for (int j = 0; j < 4; ++j) { *(LAS unsigned short*)(VT + (v0_ + 2 * j) * P64 + s_ * 2) = (unsigned short)(w[j] & 0xffffu); *(LAS unsigned short*)(VT + (v0_ + 2 * j + 1) * P64 + s_ * 2) = (unsigned short)(w[j] >> 16); } }
        __syncthreads();
        if (c + 1 < 32) HG_LOAD(c + 1);
        if (wave < 4) {
            const int sb = wave & 1, tb = wave >> 1;
            f32x16 x;
#pragma unroll
            for (int i = 0; i < 16; ++i) x[i] = 0.f;
            if (sb <= tb) {
#pragma unroll
                for (int ks = 0; ks < 8; ++ks) { const bf16x8 a = *(const LAS bf16x8*)(Kt + (32 * sb + r) * P128 + (16 * ks + 8 * hh) * 2); const bf16x8 bq = *(const LAS bf16x8*)(Qt + (32 * tb + r) * P128 + (16 * ks + 8 * hh) * 2); x = MFMA32(a, bq, x); }
            }
            const int t = 32 * tb + r;
#pragma unroll
            for (int g = 0; g < 4; ++g) {
                float v[4];
#pragma unroll
                for (int j = 0; j < 4; ++j) { const int s = 32 * sb + 8 * g + 4 * hh + j; v[j] = (s <= t && sb <= tb) ? x[4 * g + j] : 0.f; }
                u32x2 w; w.x = pk2(v[0], v[1]); w.y = pk2(v[2], v[3]);
                *(LAS u32x2*)(Am + t * P64 + (32 * sb + 8 * g + 4 * hh) * 2) = w;
            }
        }
        __syncthreads();
        const int vb = wave & 3, tb2 = wave >> 2;
        f32x16 acc;
#pragma unroll
        for (int i = 0; i < 16; ++i) acc[i] = 0.f;
#pragma unroll
        for (int ks = 0; ks < 4; ++ks) { const bf16x8 a = *(const LAS bf16x8*)(VT + (32 * vb + r) * P64 + (16 * ks + 8 * hh) * 2); const bf16x8 bb = *(const LAS bf16x8*)(Am + (32 * tb2 + r) * P64 + (16 * ks + 8 * hh) * 2); acc = MFMA32(a, bb, acc); }
#pragma unroll
        for (int ks = 0; ks < 8; ++ks) { const bf16x8 a = *(const LAS bf16x8*)(ST + (32 * vb + r) * P128 + (16 * ks + 8 * hh) * 2); const bf16x8 bb = *(const LAS bf16x8*)(Qg + (32 * tb2 + r) * P128 + (16 * ks + 8 * hh) * 2); acc = MFMA32(a, bb, acc); }
        const int kb = wave >> 1;
#pragma unroll
        for (int j = 0; j < 2; ++j) {
            const int vb2 = 2 * (wave & 1) + j;
#pragma unroll
            for (int i = 0; i < 16; ++i) st[j][i] *= dec[32 * kb + crow(i, hh)];
#pragma unroll
            for (int ks = 0; ks < 4; ++ks) { const bf16x8 a = *(const LAS bf16x8*)(KgT + (32 * kb + r) * P64 + (16 * ks + 8 * hh) * 2); const bf16x8 bb = *(const LAS bf16x8*)(VT + (32 * vb2 + r) * P64 + (16 * ks + 8 * hh) * 2); st[j] = MFMA32(a, bb, st[j]); }
        }
        { float ss = 0.f;
#pragma unroll
          for (int i = 0; i < 16; ++i) ss += acc[i] * acc[i];
          ss = pair_sum(ss);
          if (hh == 0) red[(32 * tb2 + r) * 4 + vb] = ss; }
        __syncthreads();
#pragma unroll
        for (int j = 0; j < 2; ++j) { const int vb2 = 2 * (wave & 1) + j;
#pragma unroll
            for (int g = 0; g < 4; ++g) { u32x2 w; w.x = pk2(st[j][4 * g], st[j][4 * g + 1]); w.y = pk2(st[j][4 * g + 2], st[j][4 * g + 3]);
                *(LAS u32x2*)(ST + (32 * vb2 + r) * P128 + (32 * kb + 8 * g + 4 * hh) * 2) = w; } }
        { const int t = 32 * tb2 + r; const LAS float* rp = red + t * 4;
          const float ssq = (rp[0] + rp[1]) + (rp[2] + rp[3]);
          const float rs = rsqrtf(ssq * (1.0f / 128.0f) + EPS);
          const size_t tok = tok0 + c * 64 + t;
          const bf16_t* gp = P + tok * NINP + C_HG + h * 128 + 32 * vb + 4 * hh;
          bf16_t* op = MIX + tok * DM + h * 128 + 32 * vb + 4 * hh;
#pragma unroll
          for (int g = 0; g < 4; ++g) {
              const u32x2 gw = *(const u32x2*)(gp + 8 * g);
              const float g0 = bflo(gw.x), g1 = bfhi(gw.x), g2 = bflo(gw.y), g3 = bfhi(gw.y);
              const float y0 = acc[4 * g] * rs * g0 * __builtin_amdgcn_rcpf(1.0f + fexp2(-g0 * LOG2E));
              const float y1 = acc[4 * g + 1] * rs * g1 * __builtin_amdgcn_rcpf(1.0f + fexp2(-g1 * LOG2E));
              const float y2 = acc[4 * g + 2] * rs * g2 * __builtin_amdgcn_rcpf(1.0f + fexp2(-g2 * LOG2E));
              const float y3 = acc[4 * g + 3] * rs * g3 * __builtin_amdgcn_rcpf(1.0f + fexp2(-g3 * LOG2E));
              u32x2 w; w.x = pk2(y0, y1); w.y = pk2(y2, y3);
              *(u32x2*)(op + 8 * g) = w;
          } }
    }
#undef HG_LOAD
    __syncthreads();
}

struct Args { const float* in[18]; const int* pos; float* out; unsigned char* ws; };

typedef const __attribute__((address_space(4))) Args* ArgsP;
#define ARGS() ({ ArgsP p_ = (ArgsP)__builtin_amdgcn_kernarg_segment_ptr(); asm volatile("" : "+s"(p_)); p_; })

__global__ void __launch_bounds__(512, 2) mega(Args a_unused) {
    extern __shared__ __attribute__((aligned(16))) unsigned char lds_raw[];
    LAS unsigned char* lds = (LAS unsigned char*)lds_raw;
    cg::grid_group grid = cg::this_grid();
    const int wave = __builtin_amdgcn_readfirstlane((int)threadIdx.x >> 6);
    const int G = gridDim.x;
    const int vcu = (G % 8 == 0) ? ((int)blockIdx.x % 8) * (G / 8) + (int)blockIdx.x / 8 : (int)blockIdx.x;
    const int gw = vcu * 8 + wave, NGW = G * 8;

    for (int l = 0; l < 2; ++l) {
        {
            ArgsP ap = ARGS(); unsigned char* ws = ap->ws;
            int llane = lane_id(); asm volatile("" : "+v"(llane));
            const int ltid = wave * 64 + llane;
            for (int j = (l == 0 ? 0 : 10); j < (l == 0 ? 10 : 12); ++j) {
                WJob J;
                const int jl = (j < 8) ? (j >> 2) : (j - 8) >> 1, jt = (j < 8) ? (j & 3) : 4 + ((j - 8) & 1);
                unsigned char* wlj = ws + WS_WL + (size_t)jl * WL_SIZE;
                J.W2 = nullptr; J.g2 = nullptr; J.g3 = nullptr;
                if (jt == 0) { J.W = ap->in[3] + (size_t)jl * DM * NIN; J.ldw = NIN; J.K = DM; J.nrows = NINP; J.mode = 1; J.g1 = ap->in[2] + jl * DM; J.b1 = DM; J.b2 = DM; J.WT = (bf16_t*)(wlj + WL_IN); }
                else if (jt == 1) { J.W = ap->in[8] + (size_t)jl * 512 * NQ; J.ldw = NQ; J.K = 512; J.nrows = NQP; J.mode = 2; J.g1 = ap->in[7] + jl * 512; J.b1 = 512; J.b2 = 512; J.WT = (bf16_t*)(wlj + WL_UQ); }
                else if (jt == 2) { J.W = ap->in[10] + (size_t)jl * 256 * NKV; J.ldw = NKV; J.K = 256; J.nrows = NKV; J.mode = 0; J.g1 = ap->in[9] + jl * 256; J.b1 = 256; J.b2 = 256; J.WT = (bf16_t*)(wlj + WL_UKV); }
                else if (jt == 3) { J.W = ap->in[12] + (size_t)jl * DM * DM; J.ldw = DM; J.K = DM; J.nrows = DM; J.mode = 0; J.g1 = ap->in[5] + jl * 512; J.g2 = ap->in[6] + jl * 768; J.g3 = ap->in[11] + jl * 768; J.b1 = 512; J.b2 = 1280; J.WT = (bf16_t*)(wlj + WL_O); }
                else if (jt == 4) { J.W = ap->in[14] + (size_t)jl * DM * DFF; J.W2 = ap->in[15] + (size_t)jl * DM * DFF; J.ldw = DFF; J.K = DM; J.nrows = 2 * DFF; J.mode = 3; J.g1 = ap->in[13] + jl * DM; J.b1 = DM; J.b2 = DM; J.WT = (bf16_t*)(ws + WS_WGU); }
                else { J.W = ap->in[16] + (size_t)jl * DFF * DM; J.ldw = DM; J.K = DFF; J.nrows = DM; J.mode = 0; J.g1 = nullptr; J.b1 = 0; J.b2 = 0; J.WT = (bf16_t*)(ws + WS_WDN); }
                run_wjob(J, lds, gw, NGW, llane, wave);
            }
            if (l == 0) {
                float* ssq = (float*)(ws + WS_CTL); unsigned* qctr = (unsigned*)(ws + WS_CTL + CTL_QCTR);
                const float* x_in = ap->in[0]; bf16_t* XB = (bf16_t*)(ws + WS_XB);
                int zstride = G * 512, ngw = NGW; asm volatile("" : "+s"(zstride), "+s"(ngw));
                for (int i = (int)blockIdx.x * 512 + ltid; i < (SSQ_N - 1) * 16384; i += zstride) ssq[16384 + i] = 0.f;
                if (blockIdx.x == 0 && ltid < 64) qctr[ltid] = 0u;
                for (int m = gw; m < M; m += ngw) {
                    const f32x4* xr = (const f32x4*)(x_in + (size_t)m * DM) + llane;
                    u32x2* o8 = (u32x2*)(XB + (size_t)m * DM) + llane;
                    float s = 0.f;
#pragma unroll
                    for (int jj = 0; jj < 8; ++jj) { const f32x4 v = xr[64 * jj]; s += (v.x * v.x + v.y * v.y) + (v.z * v.z + v.w * v.w); u32x2 w; w.x = pk2(v.x, v.y); w.y = pk2(v.z, v.w); o8[64 * jj] = w; }
                    s = wave_sum64(s);
                    if (llane == 0) ssq[SSQ_IN0 * 16384 + m] = s;
                }
                grid.sync();
            } else __syncthreads();
        }
        {
            ArgsP ap = ARGS(); unsigned char* ws = ap->ws; float* ssq = (float*)(ws + WS_CTL);
            pg8::Gemm g{(const bf16_t*)(ws + WS_XB), (const bf16_t*)(ws + WS_WL + (size_t)l * WL_SIZE + WL_IN), M, NINP, DM, DM}; pg8::StaticOrder S; S.init(M, NINP, G, (int)blockIdx.x);
            EpiIn E{(bf16_t*)(ws + WS_BIG), ssq + (SSQ_IN0 + l) * 16384, ssq + (SSQ_Q0 + l) * 16384, ssq + (SSQ_KV0 + l) * 16384, ap->pos};
            pg8::gemm_phase<EpiIn>(lds, g, S, E, wave);
        }
        grid.sync();
        {
            ArgsP ap = ARGS(); unsigned char* ws = ap->ws; float* ssq = (float*)(ws + WS_CTL);
            pg8::Gemm g{(const bf16_t*)(ws + WS_BIG) + C_CQ, (const bf16_t*)(ws + WS_WL + (size_t)l * WL_SIZE + WL_UQ), M, NQP, 512, NINP}; pg8::StaticOrder S; S.init(M, NQP, G, (int)blockIdx.x);
            EpiQ E{(bf16_t*)(ws + WS_XB), ssq + (SSQ_Q0 + l) * 16384, ap->pos};
            pg8::gemm_phase<EpiQ>(lds, g, S, E, wave);
        }
        {
            ArgsP ap = ARGS(); unsigned char* ws = ap->ws; float* ssq = (float*)(ws + WS_CTL);
            pg8::Gemm g{(const bf16_t*)(ws + WS_BIG) + C_CKV, (const bf16_t*)(ws + WS_WL + (size_t)l * WL_SIZE + WL_UKV), M, NKV, 256, NINP}; pg8::StaticOrder S; S.init(M, NKV, G, (int)(G - 1 - blockIdx.x));
            EpiKV E{(bf16_t*)(ws + WS_KV), ssq + (SSQ_KV0 + l) * 16384};
            pg8::gemm_phase<EpiKV>(lds, g, S, E, wave);
        }
        grid.sync();
        {
            ArgsP ap = ARGS(); unsigned char* ws = ap->ws;
            unsigned* qctr = (unsigned*)(ws + WS_CTL + CTL_QCTR);
            const bf16_t* Pb = (const bf16_t*)(ws + WS_BIG); const bf16_t* MQ = (const bf16_t*)(ws + WS_XB); const bf16_t* KVb = (const bf16_t*)(ws + WS_KV); bf16_t* MIX = (bf16_t*)(ws + WS_MIX);
            const float* lbs = ap->in[4];
            LAS unsigned* qw = (LAS unsigned*)(lds + LDS_QWORD);
            for (;;) {
                __syncthreads();
                if (wave == 0 && lane_id() == 0) *qw = atomicAdd(qctr + l, 1u);
                __syncthreads();
                const int item = (int)*qw;
                if (item >= 32 + 768) break;
                if (item < 32) hg_item(lds, Pb, MIX, lbs, l, item >> 2, item & 3, wave);
                else { const int j = item - 32, qb = 7 - j / 96, rem = j % 96, bh = rem >> 1, bb = bh / 6, hd = bh % 6;
                    if (rem & 1) sb_item(lds, Pb, MIX, bb, hd, qb, wave); else mla_item(lds, Pb, MQ, KVb, MIX, bb, hd, qb, wave); }
            }
        }
        grid.sync();
        {
            ArgsP ap = ARGS(); unsigned char* ws = ap->ws; float* ssq = (float*)(ws + WS_CTL);
            const float* xres_in = (l == 0) ? ap->in[0] : (const float*)ap->out;
            pg8::Gemm g{(const bf16_t*)(ws + WS_MIX), (const bf16_t*)(ws + WS_WL + (size_t)l * WL_SIZE + WL_O), M, DM, DM, DM}; pg8::StaticOrder S; S.init(M, DM, G, (int)blockIdx.x);
            EpiRes E{xres_in, ap->out, (bf16_t*)(ws + WS_XB), ssq + (SSQ_F0 + l) * 16384};
            pg8::gemm_phase<EpiRes>(lds, g, S, E, wave);
        }
        grid.sync();
        {
            ArgsP ap = ARGS(); unsigned char* ws = ap->ws; float* ssq = (float*)(ws + WS_CTL);
            pg8::Gemm g{(const bf16_t*)(ws + WS_XB), (const bf16_t*)(ws + WS_WGU), M, 2 * DFF, DM, DM}; pg8::StaticOrder S; S.init(M, 2 * DFF, G, (int)blockIdx.x);
            EpiGU E{(bf16_t*)(ws + WS_BIG), ssq + (SSQ_F0 + l) * 16384};
            pg8::gemm_phase<EpiGU>(lds, g, S, E, wave);
        }
        grid.sync();
        {
            ArgsP ap = ARGS(); unsigned char* ws = ap->ws; float* ssq = (float*)(ws + WS_CTL);
            pg8::Gemm g{(const bf16_t*)(ws + WS_BIG), (const bf16_t*)(ws + WS_WDN), M, DM, DFF, DFF}; pg8::StaticOrder S; S.init(M, DM, G, (int)blockIdx.x);
            EpiRes E{ap->out, ap->out, (bf16_t*)(ws + WS_XB), ssq + ((l == 0) ? SSQ_IN1 : SSQ_FIN) * 16384};
            pg8::gemm_phase<EpiRes>(lds, g, S, E, wave);
        }
        grid.sync();
    }
    {
        ArgsP ap = ARGS(); const float* ssq = (const float*)(ap->ws + WS_CTL);
        const float* gf = ap->in[17]; float* out = ap->out;
        int lane = lane_id(); asm volatile("" : "+v"(lane));
        int ngw = NGW; asm volatile("" : "+s"(ngw));
        for (int m = gw; m < M; m += ngw) {
            f32x4* o = (f32x4*)(out + (size_t)m * DM) + lane;
            const float rs = rsqrtf(ssq[SSQ_FIN * 16384 + m] * (1.0f / DM) + EPS);
#pragma unroll
            for (int j = 0; j < 8; ++j) { f32x4 v = o[64 * j]; const f32x4 gg = ((const f32x4*)gf)[lane + 64 * j]; v = v * rs * gg; o[64 * j] = v; }
        }
    }
}

extern "C" void kernel_launch(void* const* d_in, const int* in_sizes, int n_in, void* d_out, int out_size, void* d_ws, size_t ws_size, hipStream_t stream) {
    static int grid = 0;
    if (grid == 0) {
        int dev = 0, cus = 0, per_cu = 0;
        (void)hipGetDevice(&dev);
        (void)hipDeviceGetAttribute(&cus, hipDeviceAttributeMultiprocessorCount, dev);
        (void)hipFuncSetAttribute((const void*)mega, hipFuncAttributeMaxDynamicSharedMemorySize, LDS_BYTES);
        (void)hipOccupancyMaxActiveBlocksPerMultiprocessor(&per_cu, (const void*)mega, 512, LDS_BYTES);
        grid = cus > 0 ? cus : 256;
        if (ws_size < WS_END) { fprintf(stderr, "kernel_launch: workspace too small: %zu < %zu\n", ws_size, (size_t)WS_END); grid = -1; }
        fprintf(stderr, "kernel_launch: cus %d per_cu %d grid %d ws %zu\n", cus, per_cu, grid, ws_size);
    }
    if (grid < 0) return;
    Args a{};
    for (int i = 0; i < 18; ++i) a.in[i] = (const float*)d_in[i];
    a.pos = (const int*)d_in[1];
    a.out = (float*)d_out; a.ws = (unsigned char*)d_ws;
    void* args[] = {&a};
    hipError_t e = hipLaunchCooperativeKernel((const void*)mega, dim3(grid), dim3(512), args, LDS_BYTES, stream);
    if (e != hipSuccess) fprintf(stderr, "cooperative launch failed: %s\n", hipGetErrorString(e));
}
```

```cpp
#include <hip/hip_runtime.h>
#include <hip/hip_cooperative_groups.h>
#include <cstdio>
namespace cg = cooperative_groups;

#define LAS __attribute__((address_space(3)))
typedef unsigned short bf16_t;
typedef short bf16x8 __attribute__((ext_vector_type(8)));
typedef short s16x4 __attribute__((ext_vector_type(4)));
typedef float f32x4 __attribute__((ext_vector_type(4)));
typedef float f32x2 __attribute__((ext_vector_type(2)));
typedef float f32x16 __attribute__((ext_vector_type(16)));
typedef unsigned u32x4 __attribute__((ext_vector_type(4)));
typedef unsigned u32x2 __attribute__((ext_vector_type(2)));
typedef __bf16 bf16x2n __attribute__((ext_vector_type(2)));
#define DI __device__ __forceinline__
#define MFMA32(a, b, c) __builtin_amdgcn_mfma_f32_32x32x16_bf16((a), (b), (c), 0, 0, 0)

constexpr int M = 16384, DM = 2048, SEQ = 2048, NB = 8;
constexpr int NIN = 5184, NINP = 5376, DFF = 5632;
constexpr int PP = 5632;
constexpr int C_HQ = 0, C_HF = 512, C_HV = 1024, C_HG = 1536, C_SQ = 2048, C_SK = 2816, C_SV = 3584, C_CQ = 4352, C_CKV = 4864, C_KR = 5120;
constexpr int NQ = 1152, NQP = 1280, NKV = 1536;
constexpr float EPS = 1e-6f;
constexpr float LOG2E = 1.4426950408889634f, LN2 = 0.6931471805599453f;

constexpr size_t MiB = 1u << 20;
constexpr size_t WS_CTL = 0;
constexpr size_t WS_WL = 2 * MiB;
constexpr size_t WL_IN = 0, WL_UQ = 21 * MiB, WL_UKV = WL_UQ + 1310720, WL_O = 23 * MiB, WL_SIZE = 31 * MiB;
constexpr size_t WS_WGU = 64 * MiB, WS_WDN = 108 * MiB;
constexpr size_t WS_XB = 130 * MiB;
constexpr size_t WS_BIG = 194 * MiB;
constexpr size_t WS_MIX = 370 * MiB;
constexpr size_t WS_KV = 434 * MiB;
constexpr size_t WS_END = 482 * MiB;
constexpr size_t DO_WGU1 = 40 * MiB, DO_WDN1 = 84 * MiB;
enum { SSQ_IN0 = 0, SSQ_IN1, SSQ_Q0, SSQ_Q1, SSQ_KV0, SSQ_KV1, SSQ_F0, SSQ_F1, SSQ_FIN, SSQ_N };
constexpr size_t CTL_QCTR = 30 * 65536;
typedef unsigned long long ssq_t;
DI float ssq_get(const ssq_t* p, int row) { return (float)p[row] * (1.0f / 16777216.0f); }
DI void ssq_add(ssq_t* p, int row, float s) { atomicAdd(p + row, (ssq_t)(s * 16777216.0f)); }

constexpr int LDS_BYTES = 139264;
constexpr int LDS_QWORD = 136704;
#ifndef GU_REPS
#define GU_REPS 1
#endif
#ifndef W_REPS
#define W_REPS 1
#endif
#ifndef P2_REPS
#define P2_REPS 1
#endif
#ifndef HGA_REPS
#define HGA_REPS 1
#endif
#ifndef MIX_REPS
#define MIX_REPS 1
#endif

DI int lane_id() { int l; asm volatile("v_mbcnt_lo_u32_b32 %0, -1, 0\n\tv_mbcnt_hi_u32_b32 %0, -1, %0" : "=v"(l)); return l; }
DI unsigned pk2(float a, float b) { f32x2 v = {a, b}; bf16x2n r = __builtin_convertvector(v, bf16x2n); return __builtin_bit_cast(unsigned, r); }
DI float bf2f(unsigned short u) { return __uint_as_float(((unsigned)u) << 16); }
DI float bflo(unsigned w) { return __uint_as_float(w << 16); }
DI float bfhi(unsigned w) { return __uint_as_float(w & 0xffff0000u); }
DI float fexp2(float x) { return __builtin_amdgcn_exp2f(x); }
DI float flog2(float x) { return __builtin_amdgcn_logf(x); }
DI float pair_sum(float v) { auto rr = __builtin_amdgcn_permlane32_swap(__float_as_uint(v), __float_as_uint(v), false, false); return __uint_as_float(rr[0]) + __uint_as_float(rr[1]); }
DI float pair_max(float v) { auto rr = __builtin_amdgcn_permlane32_swap(__float_as_uint(v), __float_as_uint(v), false, false); return fmaxf(__uint_as_float(rr[0]), __uint_as_float(rr[1])); }

namespace pg8 {
constexpr int BM = 256, BK = 64, HALF = 128, HTB = HALF * BK * 2, STAGE_BYTES = 8 * HTB, NXCD = 8, WGM = 4;
DI int lds_byte(int r, int c) { const int st = (r >> 4) * 2 + (c >> 5), rr = r & 15, cc = c & 31, ob = rr * 64 + cc * 2; return st * 1024 + (ob ^ (((ob >> 9) & 1) << 5)); }
DI void stage_rc(int b, int& R, int& C) { const int st = b / 1024, sb = b % 1024, swz = sb ^ (((sb >> 9) & 1) << 5); R = (st >> 1) * 16 + swz / 64; C = (st & 1) * 32 + (swz % 64) / 2; }
DI int perm32(int rho) { const int n = rho >> 4, i = rho & 15; return 8 * (i >> 2) + 4 * n + (i & 3); }
struct Unit { int pm, pn; };
struct Gemm { const bf16_t* A; const bf16_t* Bt; int M, N, K, lda; };
struct StaticOrder {
    int nM, nN, nwg, G, c, wgm;
    DI void init(int M_, int N_, int G_, int c_, int wgm_ = WGM) { nM = M_ / BM; nN = N_ / BM; nwg = nM * nN; G = G_; c = c_; wgm = wgm_; }
    DI bool next(int i, Unit& u) const {
        const long L = (long)i * G + c; if (L >= nwg) return false;
        int wgid = (int)L; { const int q = nwg / NXCD, r = nwg % NXCD, xcd = wgid % NXCD, off = wgid / NXCD; wgid = (xcd < r ? xcd * (q + 1) : r * (q + 1) + (xcd - r) * q) + off; }
        const int nig = wgm * nN, gid = wgid / nig, fm = gid * wgm, gsz = (nM - fm) < wgm ? (nM - fm) : wgm;
        u.pm = fm + ((wgid % nig) % gsz); u.pn = (wgid % nig) / gsz; return true;
    }
};
template <class Epi, bool TAIL20 = false>
DI void gemm_phase(LAS unsigned char* lds, const Gemm g, const StaticOrder& S_in, const Epi& E, int wid) {
    asm volatile("" : "+s"(wid));
    StaticOrder S = S_in; asm volatile("" : "+s"(S.c), "+s"(S.G));
    int lane = lane_id(); asm volatile("" : "+v"(lane));
    const int tid = wid * 64 + lane, wr = wid >> 2, wc = wid & 3, fr = lane & 15, fq = lane >> 4;
    const int K = g.K, nt = K / BK, lda = g.lda;
    unsigned voffA[2], voffB[2];
#pragma unroll
    for (int i = 0; i < 2; ++i) { int R, C; stage_rc(tid * 16 + i * 8192, R, C); const int Rb = (R & ~31) + perm32(R & 31);
        voffA[i] = (unsigned)(R * lda + C) * 2u; voffB[i] = (unsigned)(Rb * K + C) * 2u; }
    const size_t kstep = (size_t)(BK * 2);
    const size_t hstepA = (size_t)HALF * lda * 2, hstepB = (size_t)HALF * K * 2;
    const size_t tstepA = 2 * hstepA, tstepB = 2 * hstepB;
    const unsigned ldsw = (unsigned)wid * 1024u;
    const int aoff = lds_byte(wr * 64 + fr, fq * 8), boff = lds_byte(wc * 32 + fr, fq * 8);
#define PG8_SA(b, h) (((b) * 2 + (h)) * HTB)
#define PG8_SB(b, h) ((4 + (b) * 2 + (h)) * HTB)
#define PG8_STAGE(bufoff, gbase, voff) do { _Pragma("unroll") for (int _i = 0; _i < 2; ++_i) \
        __builtin_amdgcn_global_load_lds((const unsigned*)((const char*)(gbase) + (voff)[_i]), (LAS unsigned*)(lds + (bufoff) + ldsw + _i * 8192), 16, 0, 0); } while (0)
#define PG8_LDA(dst, b, h) do { _Pragma("unroll") for (int m = 0; m < 4; ++m) _Pragma("unroll") for (int k = 0; k < 2; ++k) dst[m][k] = *(const LAS bf16x8*)(lds + PG8_SA(b, h) + aoff + m * 2048 + k * 1024); } while (0)
#define PG8_LDB(dst, b, h) do { _Pragma("unroll") for (int n = 0; n < 2; ++n) _Pragma("unroll") for (int k = 0; k < 2; ++k) dst[n][k] = *(const LAS bf16x8*)(lds + PG8_SB(b, h) + boff + n * 2048 + k * 1024); } while (0)
#define PG8_MMA(ai, bj, At, Bt) do { __builtin_amdgcn_s_setprio(1); _Pragma("unroll") for (int m = 0; m < 4; ++m) _Pragma("unroll") for (int n = 0; n < 2; ++n) _Pragma("unroll") for (int k = 0; k < 2; ++k) \
        acc[ai][bj][m][n] = __builtin_amdgcn_mfma_f32_16x16x32_bf16(Bt[n][k], At[m][k], acc[ai][bj][m][n], 0, 0, 0); __builtin_amdgcn_s_setprio(0); } while (0)
#define PG8_WAIT_V(n) asm volatile("s_waitcnt vmcnt(" #n ")" ::: "memory")
#define PG8_WAIT_L(n) asm volatile("s_waitcnt lgkmcnt(" #n ")" ::: "memory")
#define PG8_BAR __builtin_amdgcn_s_barrier()
#define PG8_SCHED __builtin_amdgcn_sched_barrier(0)
#define PG8_KLOOP(MMAB1) \
        for (int t = 0; t < nt; t += 2) { \
            const bool last = (t == nt - 2); \
            const char* a1 = cA + (size_t)(t + 1) * kstep; \
            const char* a2 = last ? nA : cA + (size_t)(t + 2) * kstep; const char* b2 = last ? nB : cB + (size_t)(t + 2) * kstep; \
            const char* a3 = a2 + kstep; const char* b3 = b2 + kstep; \
            PG8_LDB(B0, 0, 0); PG8_SCHED; PG8_LDA(At, 0, 0); PG8_STAGE(PG8_SA(1, 1), a1 + hstepA, voffA); \
            PG8_WAIT_L(8); PG8_BAR; PG8_WAIT_L(0); PG8_MMA(0, 0, At, B0); PG8_BAR; PG8_SCHED; \
            PG8_LDB(B1, 0, 1); PG8_STAGE(PG8_SB(0, 0), b2, voffB); \
            PG8_BAR; PG8_WAIT_L(0); if (MMAB1) PG8_MMA(0, 1, At, B1); PG8_BAR; \
            PG8_LDA(At, 0, 1); PG8_STAGE(PG8_SA(0, 0), a2, voffA); \
            PG8_BAR; PG8_WAIT_L(0); PG8_MMA(1, 0, At, B0); PG8_BAR; PG8_SCHED; \
            PG8_STAGE(PG8_SB(0, 1), b2 + hstepB, voffB); \
            PG8_WAIT_V(6); PG8_BAR; if (MMAB1) PG8_MMA(1, 1, At, B1); PG8_BAR; \
            PG8_LDB(B0, 1, 0); PG8_SCHED; PG8_LDA(At, 1, 0); PG8_STAGE(PG8_SA(0, 1), a2 + hstepA, voffA); \
            PG8_WAIT_L(8); PG8_BAR; PG8_WAIT_L(0); PG8_MMA(0, 0, At, B0); PG8_BAR; PG8_SCHED; \
            PG8_LDB(B1, 1, 1); PG8_STAGE(PG8_SB(1, 0), b3, voffB); \
            PG8_BAR; PG8_WAIT_L(0); if (MMAB1) PG8_MMA(0, 1, At, B1); PG8_BAR; \
            PG8_LDA(At, 1, 1); PG8_STAGE(PG8_SA(1, 0), a3, voffA); \
            PG8_BAR; PG8_WAIT_L(0); PG8_MMA(1, 0, At, B0); PG8_BAR; PG8_SCHED; \
            PG8_STAGE(PG8_SB(1, 1), b3 + hstepB, voffB); \
            PG8_WAIT_V(6); PG8_BAR; if (MMAB1) PG8_MMA(1, 1, At, B1); PG8_BAR; \
        }
    Unit cur, nxt; int ui = 0;
#define PG8_NEXT(i, u) (TAIL20 ? (((i) < 5) ? S.next((i), (u)) : (((i) == 5 && S.c < 64) ? ((u).pm = S.c, (u).pn = 20, true) : false)) : S.next((i), (u)))
    if (!PG8_NEXT(0, cur)) return;
    f32x4 acc[2][2][4][2];
#pragma unroll
    for (int a = 0; a < 2; ++a)
#pragma unroll
        for (int b = 0; b < 2; ++b)
#pragma unroll
            for (int m = 0; m < 4; ++m)
#pragma unroll
                for (int n = 0; n < 2; ++n) acc[a][b][m][n] = (f32x4){0.f, 0.f, 0.f, 0.f};
    bf16x8 At[4][2], B0[2][2], B1[2][2];
    const char* cA = (const char*)g.A + (size_t)cur.pm * tstepA; const char* cB = (const char*)g.Bt + (size_t)cur.pn * tstepB;
    PG8_STAGE(PG8_SB(0, 0), cB, voffB); PG8_STAGE(PG8_SA(0, 0), cA, voffA); PG8_STAGE(PG8_SB(0, 1), cB + hstepB, voffB); PG8_STAGE(PG8_SA(0, 1), cA + hstepA, voffA);
    if (wr == 1) PG8_BAR;
    PG8_WAIT_V(4); PG8_BAR;
    PG8_STAGE(PG8_SB(1, 0), cB + kstep, voffB); PG8_STAGE(PG8_SA(1, 0), cA + kstep, voffA); PG8_STAGE(PG8_SB(1, 1), cB + hstepB + kstep, voffB);
    PG8_WAIT_V(6); PG8_BAR;
    for (;;) {
        const bool has_next = PG8_NEXT(ui + 1, nxt);
        const char* nA = has_next ? (const char*)g.A + (size_t)nxt.pm * tstepA : cA; const char* nB = has_next ? (const char*)g.Bt + (size_t)nxt.pn * tstepB : cB;
        if (TAIL20 && cur.pn == 20) { PG8_KLOOP(false) } else { PG8_KLOOP(true) }
        E(acc, cur, wr, wc, fr, fq);
        if (!has_next) break;
#pragma unroll
        for (int a = 0; a < 2; ++a)
#pragma unroll
            for (int b = 0; b < 2; ++b)
#pragma unroll
                for (int m = 0; m < 4; ++m)
#pragma unroll
                    for (int n = 0; n < 2; ++n) acc[a][b][m][n] = (f32x4){0.f, 0.f, 0.f, 0.f};
        cur = nxt; cA = nA; cB = nB; ++ui;
    }
    PG8_WAIT_V(0);
    if (wr == 0) PG8_BAR;
    PG8_BAR;
#undef PG8_KLOOP
#undef PG8_NEXT
#undef PG8_SA
#undef PG8_SB
#undef PG8_STAGE
#undef PG8_LDA
#undef PG8_LDB
#undef PG8_MMA
#undef PG8_WAIT_V
#undef PG8_WAIT_L
#undef PG8_BAR
#undef PG8_SCHED
}
}

typedef f32x4 AccT[2][2][4][2];

DI void rope8(f32x4& v0, f32x4& v1, int pos, int i0) {
    const float fp = (float)pos;
    float x[8] = {v0[0], v0[1], v0[2], v0[3], v1[0], v1[1], v1[2], v1[3]};
#pragma unroll
    for (int p = 0; p < 4; ++p) {
        const float invf = fexp2(-(float)(i0 + p) * 0.41524101186092029f);
        const float rev = __builtin_amdgcn_fractf(fp * invf * 0.15915494309189535f);
        const float sn = __builtin_amdgcn_sinf(rev), cs = __builtin_amdgcn_cosf(rev);
        const float x1 = x[2 * p], x2 = x[2 * p + 1];
        x[2 * p] = x1 * cs - x2 * sn; x[2 * p + 1] = x2 * cs + x1 * sn;
    }
    v0 = (f32x4){x[0], x[1], x[2], x[3]}; v1 = (f32x4){x[4], x[5], x[6], x[7]};
}
DI float quad_sum(float s) {
    auto r = __builtin_amdgcn_permlane16_swap(__float_as_uint(s), __float_as_uint(s), false, false);
    s = __uint_as_float(r[0]) + __uint_as_float(r[1]);
    return pair_sum(s);
}
#define DPP_ADD(s, ctrl) (s) += __uint_as_float((unsigned)__builtin_amdgcn_update_dpp(0, (int)__float_as_uint(s), (ctrl), 0xf, 0xf, true))
DI float wave_sum64(float s) {
    DPP_ADD(s, 0xB1); DPP_ADD(s, 0x4E);
    DPP_ADD(s, 0x141); DPP_ADD(s, 0x140);
    return quad_sum(s);
}

struct EpiIn {
    bf16_t* P; const ssq_t* ssq_in; ssq_t* ssq_q; ssq_t* ssq_kv; const int* pos;
    DI void operator()(const AccT& acc, const pg8::Unit& u, int wr, int wc, int fr, int fq) const {
        const int row0 = u.pm * 256 + wr * 64 + fr, col0 = u.pn * 256 + wc * 32 + 8 * fq;
        const bool do_rope = (u.pn == 20) && (wc < 2);
        ssq_t* ssq = (u.pn == 17 || u.pn == 18) ? ssq_q : (u.pn == 19 ? ssq_kv : nullptr);
        ssq_t raw[8];
#pragma unroll
        for (int i = 0; i < 8; ++i) raw[i] = ssq_in[row0 + (i >> 2) * 128 + (i & 3) * 16];
#pragma unroll
        for (int ai = 0; ai < 2; ++ai)
#pragma unroll
            for (int m = 0; m < 4; ++m) {
                const int row = row0 + ai * 128 + m * 16;
                const float sc = rsqrtf((float)raw[ai * 4 + m] * (1.0f / 16777216.0f) * (1.0f / DM) + EPS);
                float s = 0.f;
#pragma unroll
                for (int bj = 0; bj < 2; ++bj) {
                    f32x4 v0 = acc[ai][bj][m][0] * sc, v1 = acc[ai][bj][m][1] * sc;
                    if (do_rope && bj == 0) rope8(v0, v1, pos[row], 16 * wc + 4 * fq);
                    s += (v0[0] * v0[0] + v0[1] * v0[1]) + (v0[2] * v0[2] + v0[3] * v0[3]) + (v1[0] * v1[0] + v1[1] * v1[1]) + (v1[2] * v1[2] + v1[3] * v1[3]);
                    u32x4 w; w.x = pk2(v0[0], v0[1]); w.y = pk2(v0[2], v0[3]); w.z = pk2(v1[0], v1[1]); w.w = pk2(v1[2], v1[3]);
                    *(u32x4*)(P + (size_t)row * PP + col0 + bj * 128) = w;
                }
                if (ssq) { s = quad_sum(s); if (fq == 0) ssq_add(ssq, row, s); }
            }
    }
};
struct EpiQ {
    bf16_t* Q; const ssq_t* ssq_q; const int* pos;
    DI void operator()(const AccT& acc, const pg8::Unit& u, int wr, int wc, int fr, int fq) const {
        const int row0 = u.pm * 256 + wr * 64 + fr, col0 = u.pn * 256 + wc * 32 + 8 * fq;
        ssq_t raw[8];
#pragma unroll
        for (int i = 0; i < 8; ++i) raw[i] = ssq_q[row0 + (i >> 2) * 128 + (i & 3) * 16];
#pragma unroll
        for (int ai = 0; ai < 2; ++ai)
#pragma unroll
            for (int m = 0; m < 4; ++m) {
                const int row = row0 + ai * 128 + m * 16;
                const float sc = rsqrtf((float)raw[ai * 4 + m] * (1.0f / 16777216.0f) * (1.0f / 512.0f) + EPS);
                const int ps = pos[row];
#pragma unroll
                for (int bj = 0; bj < 2; ++bj) {
                    const int c = col0 + bj * 128;
                    if (c < NQ) {
                        f32x4 v0 = acc[ai][bj][m][0] * sc, v1 = acc[ai][bj][m][1] * sc;
                        const int within = c % 192;
                        if (within >= 128) rope8(v0, v1, ps, (within - 128) >> 1);
                        u32x4 w; w.x = pk2(v0[0], v0[1]); w.y = pk2(v0[2], v0[3]); w.z = pk2(v1[0], v1[1]); w.w = pk2(v1[2], v1[3]);
                        *(u32x4*)(Q + (size_t)row * NQ + c) = w;
                    }
                }
            }
    }
};
struct EpiKV {
    bf16_t* KV; const ssq_t* ssq_kv;
    DI void operator()(const AccT& acc, const pg8::Unit& u, int wr, int wc, int fr, int fq) const {
        const int row0 = u.pm * 256 + wr * 64 + fr, col0 = u.pn * 256 + wc * 32 + 8 * fq;
        ssq_t raw[8];
#pragma unroll
        for (int i = 0; i < 8; ++i) raw[i] = ssq_kv[row0 + (i >> 2) * 128 + (i & 3) * 16];
#pragma unroll
        for (int ai = 0; ai < 2; ++ai)
#pragma unroll
            for (int m = 0; m < 4; ++m) {
                const int row = row0 + ai * 128 + m * 16;
                const float sc = rsqrtf((float)raw[ai * 4 + m] * (1.0f / 16777216.0f) * (1.0f / 256.0f) + EPS);
#pragma unroll
                for (int bj = 0; bj < 2; ++bj) {
                    const f32x4 v0 = acc[ai][bj][m][0] * sc, v1 = acc[ai][bj][m][1] * sc;
                    u32x4 w; w.x = pk2(v0[0], v0[1]); w.y = pk2(v0[2], v0[3]); w.z = pk2(v1[0], v1[1]); w.w = pk2(v1[2], v1[3]);
                    *(u32x4*)(KV + (size_t)row * NKV + col0 + bj * 128) = w;
                }
            }
    }
};
struct EpiRes {
    bf16_t* XB; ssq_t* ssq_out;
    DI void operator()(const AccT& acc, const pg8::Unit& u, int wr, int wc, int fr, int fq) const {
        const int row0 = u.pm * 256 + wr * 64 + fr, col0 = u.pn * 256 + wc * 32 + 8 * fq;
#pragma unroll
        for (int ai = 0; ai < 2; ++ai) {
            u32x4 old[4][2];
#pragma unroll
            for (int m = 0; m < 4; ++m)
#pragma unroll
                for (int bj = 0; bj < 2; ++bj) old[m][bj] = *(const u32x4*)(XB + (size_t)(row0 + ai * 128 + m * 16) * DM + col0 + bj * 128);
#pragma unroll
            for (int m = 0; m < 4; ++m) {
                const int row = row0 + ai * 128 + m * 16;
                float s = 0.f;
#pragma unroll
                for (int bj = 0; bj < 2; ++bj) {
                    const size_t off = (size_t)row * DM + col0 + bj * 128;
                    const u32x4 o = old[m][bj];
                    const f32x4 v0 = acc[ai][bj][m][0] + (f32x4){bflo(o.x), bfhi(o.x), bflo(o.y), bfhi(o.y)};
                    const f32x4 v1 = acc[ai][bj][m][1] + (f32x4){bflo(o.z), bfhi(o.z), bflo(o.w), bfhi(o.w)};
                    s += (v0[0] * v0[0] + v0[1] * v0[1]) + (v0[2] * v0[2] + v0[3] * v0[3]) + (v1[0] * v1[0] + v1[1] * v1[1]) + (v1[2] * v1[2] + v1[3] * v1[3]);
                    u32x4 w; w.x = pk2(v0[0], v0[1]); w.y = pk2(v0[2], v0[3]); w.z = pk2(v1[0], v1[1]); w.w = pk2(v1[2], v1[3]);
                    *(u32x4*)(XB + off) = w;
                }
                s = quad_sum(s); if (fq == 0) ssq_add(ssq_out, row, s);
            }
            asm volatile("" ::: "memory");
        }
    }
};
struct EpiGU {
    bf16_t* H; const ssq_t* ssq_f;
    DI void operator()(const AccT& acc, const pg8::Unit& u, int wr, int wc, int fr, int fq) const {
        const int row0 = u.pm * 256 + wr * 64 + fr, col0 = u.pn * 128 + wc * 32 + 8 * fq;
        ssq_t raw[8];
#pragma unroll
        for (int i = 0; i < 8; ++i) raw[i] = ssq_f[row0 + (i >> 2) * 128 + (i & 3) * 16];
#pragma unroll
        for (int ai = 0; ai < 2; ++ai)
#pragma unroll
            for (int m = 0; m < 4; ++m) {
                const int row = row0 + ai * 128 + m * 16;
                const float sc = rsqrtf((float)raw[ai * 4 + m] * (1.0f / 16777216.0f) * (1.0f / DM) + EPS);
                float hv[8];
#pragma unroll
                for (int n = 0; n < 2; ++n)
#pragma unroll
                    for (int j = 0; j < 4; ++j) { const float gt = acc[ai][0][m][n][j] * sc, up = acc[ai][1][m][n][j] * sc;
                        hv[n * 4 + j] = gt * __builtin_amdgcn_rcpf(1.0f + fexp2(-gt * LOG2E)) * up; }
                u32x4 w; w.x = pk2(hv[0], hv[1]); w.y = pk2(hv[2], hv[3]); w.z = pk2(hv[4], hv[5]); w.w = pk2(hv[6], hv[7]);
                *(u32x4*)(H + (size_t)row * DFF + col0) = w;
            }
    }
};
struct EpiNone { float* sink; DI void operator()(const AccT& acc, const pg8::Unit& u, int wr, int wc, int fr, int fq) const { f32x4 t = {0.f, 0.f, 0.f, 0.f};
#pragma unroll
    for (int a = 0; a < 2; ++a)
#pragma unroll
        for (int b = 0; b < 2; ++b)
#pragma unroll
            for (int m = 0; m < 4; ++m)
#pragma unroll
                for (int n = 0; n < 2; ++n) t += acc[a][b][m][n];
    const float s = (t[0] + t[1]) + (t[2] + t[3]); if (s == 1.2345e30f) sink[0] = s; } };
struct WJob { const float* W; const float* W2; int ldw, K, nrows, mode; const float* g1; const float* g2; const float* g3; int b1, b2; bf16_t* WT; };
DI void wjob_item(const WJob& J, int item, int lane) {
    const int nblk = J.nrows >> 7, kb = item / nblk, nb = item - kb * nblk, k0 = 64 * kb, n0 = 128 * nb;
    const bool has_gain = (J.g1 != nullptr);
    const float* gp = J.g1 + k0; if (k0 >= J.b2) gp = J.g3 + (k0 - J.b2); else if (k0 >= J.b1) gp = J.g2 + (k0 - J.b1);
    bool fast = false;
    if (J.mode == 0) fast = (n0 + 128 <= J.ldw); else if (J.mode == 1) fast = (n0 + 128 <= C_KR); else if (J.mode == 3) fast = true;
    if (fast) {
        const float* src = J.W + n0 + 2 * lane;
        if (J.mode == 3) src = ((nb & 1) ? J.W2 : J.W) + (nb >> 1) * 128 + 2 * lane;
        bf16_t* dst = J.WT + (size_t)(n0 + 2 * lane) * J.K + k0;
        f32x2 v[64];
#pragma unroll
        for (int j = 0; j < 64; ++j) v[j] = *(const f32x2*)(src + (size_t)(k0 + j) * J.ldw);
        if (has_gain) {
#pragma unroll
            for (int j = 0; j < 64; ++j) v[j] = v[j] * gp[j];
        }
#pragma unroll
        for (int i = 0; i < 2; ++i)
#pragma unroll
            for (int g = 0; g < 8; ++g) {
                u32x4 o; o.x = pk2(v[8 * g][i], v[8 * g + 1][i]); o.y = pk2(v[8 * g + 2][i], v[8 * g + 3][i]); o.z = pk2(v[8 * g + 4][i], v[8 * g + 5][i]); o.w = pk2(v[8 * g + 6][i], v[8 * g + 7][i]);
                *(u32x4*)(dst + (size_t)i * J.K + 8 * g) = o;
            }
    } else {
        for (int q = 0; q < 2; ++q) {
            const int n = n0 + lane + 64 * q;
            int col = -1;
            if (J.mode == 0) { if (n < J.ldw) col = n; }
            else if (J.mode == 1) { if (n < C_KR) col = n; else if (n < NIN) { const int j = n - C_KR; col = C_KR + (j >> 1) + 32 * (j & 1); } }
            else if (J.mode == 2) { if (n < NQ) { const int hd = n / 192, w = n % 192; if (w < 128) col = n; else { const int j = w - 128; col = hd * 192 + 128 + (j >> 1) + 32 * (j & 1); } } }
            bf16_t* dst = J.WT + (size_t)n * J.K + k0;
            const float msk = (col >= 0) ? 1.0f : 0.0f;
            const float* sp = J.W + (size_t)k0 * J.ldw + (col >= 0 ? col : 0);
            float v[64];
#pragma unroll
            for (int j = 0; j < 64; ++j) v[j] = sp[(size_t)j * J.ldw];
#pragma unroll
            for (int j = 0; j < 64; ++j) v[j] *= has_gain ? msk * gp[j] : msk;
#pragma unroll
            for (int g = 0; g < 8; ++g) {
                u32x4 o; o.x = pk2(v[8 * g], v[8 * g + 1]); o.y = pk2(v[8 * g + 2], v[8 * g + 3]); o.z = pk2(v[8 * g + 4], v[8 * g + 5]); o.w = pk2(v[8 * g + 6], v[8 * g + 7]);
                *(u32x4*)(dst + 8 * g) = o;
            }
        }
    }
}
DI void run_wjob(const WJob& J, LAS unsigned char* lds, int gw, int NGW, int lane, int wave) {
    const int nitems = (J.K / 32) * (J.nrows >> 8);
    asm volatile("" : "+s"(NGW));
    for (int it = gw; it < nitems; it += NGW) wjob_item(J, it, lane);
}

#define LDS_BARRIER() do { asm volatile("s_waitcnt lgkmcnt(0)" ::: "memory"); __builtin_amdgcn_s_barrier(); asm volatile("" ::: "memory"); } while (0)
DI int crow(int i, int hh) { return (i & 3) + 8 * (i >> 2) + 4 * hh; }
DI bf16x8 pack8(const f32x16& x, int s) {
    u32x4 p = {pk2(x[8 * s], x[8 * s + 1]), pk2(x[8 * s + 2], x[8 * s + 3]), pk2(x[8 * s + 4], x[8 * s + 5]), pk2(x[8 * s + 6], x[8 * s + 7])};
    return __builtin_bit_cast(bf16x8, p);
}
DI bf16x8 tr_pair(LAS unsigned char* p_lo) {
    const s16x4 lo = __builtin_amdgcn_ds_read_tr16_b64_v4i16((LAS s16x4*)p_lo);
    const s16x4 hi = __builtin_amdgcn_ds_read_tr16_b64_v4i16((LAS s16x4*)(p_lo + 8 * 320));
    return __builtin_shufflevector(lo, hi, 0, 1, 2, 3, 4, 5, 6, 7);
}
constexpr int VPITCH = 320;
constexpr float SB_DEAD = 200.0f;

DI void pv_step(f32x16 (&o)[4], LAS unsigned char* Vs, const bf16x8& pb, int hf, int ks2, int lane) {
    const int i16 = lane & 15, q = i16 >> 2, p = i16 & 3, blk = (lane >> 4) & 1, hh = lane >> 5;
    LAS unsigned char* base = Vs + (32 * hf + 16 * ks2 + 4 * hh + q) * VPITCH + 32 * blk + 8 * p;
#pragma unroll
    for (int db = 0; db < 4; ++db) { const bf16x8 a = tr_pair(base + db * 64); o[db] = MFMA32(a, pb, o[db]); }
}
DI void out_norm_store(f32x16 (&o)[4], float pre, bf16_t* dst_row, int hh) {
    float ss = 0.f;
#pragma unroll
    for (int db = 0; db < 4; ++db)
#pragma unroll
        for (int i = 0; i < 16; ++i) { o[db][i] *= pre; ss += o[db][i] * o[db][i]; }
    ss = pair_sum(ss);
    const float rs = rsqrtf(ss * (1.0f / 128.0f) + EPS);
#pragma unroll
    for (int db = 0; db < 4; ++db)
#pragma unroll
        for (int g = 0; g < 4; ++g) {
            u32x2 w; w.x = pk2(o[db][4 * g] * rs, o[db][4 * g + 1] * rs); w.y = pk2(o[db][4 * g + 2] * rs, o[db][4 * g + 3] * rs);
            *(u32x2*)(dst_row + 32 * db + 8 * g + 4 * hh) = w;
        }
}

DI void sb_item(LAS unsigned char* lds, const bf16_t* P, bf16_t* MIX, int b, int h, int qb, int wave_) {
    const int tid = wave_ * 64 + lane_id();
    const int lane = tid & 63, wave = wave_, r = lane & 31, hh = lane >> 5;
    const size_t tok0 = (size_t)b * SEQ;
    const int tq0 = qb * 256 + wave * 32;
    constexpr int KP = 272;
    LAS unsigned char* Ks = lds; LAS unsigned char* Vs = lds + 64 * KP;
    bf16x8 qf[8];
    { const bf16_t* qp = P + (tok0 + tq0 + r) * PP + C_SQ + h * 128 + hh * 8;
#pragma unroll
      for (int ks = 0; ks < 8; ++ks) qf[ks] = *(const bf16x8*)(qp + ks * 16); }
    f32x16 o[4];
#pragma unroll
    for (int db = 0; db < 4; ++db)
#pragma unroll
        for (int i = 0; i < 16; ++i) o[db][i] = 0.f;
    float carry = 0.f;
    const int ntiles = 4 * qb + 4;
    const float scale = 0.08838834764831845f;
    u32x4 kreg[2], vreg[2];
    const bf16_t* kbase = P + tok0 * PP + C_SK + h * 128;
    const bf16_t* vbase = P + tok0 * PP + C_SV + h * 128;
#define SB_LOAD(kt) do { _Pragma("unroll") for (int i_ = 0; i_ < 2; ++i_) { const int c_ = tid + 512 * i_, row_ = c_ >> 4, col_ = c_ & 15; \
        const size_t go_ = (size_t)((kt) * 64 + row_) * PP + col_ * 8; kreg[i_] = *(const u32x4*)(kbase + go_); vreg[i_] = *(const u32x4*)(vbase + go_); } } while (0)
#define SB_STORE() do { _Pragma("unroll") for (int i_ = 0; i_ < 2; ++i_) { const int c_ = tid + 512 * i_, row_ = c_ >> 4, col_ = c_ & 15; \
        *(LAS u32x4*)(Ks + row_ * KP + col_ * 16) = kreg[i_]; *(LAS u32x4*)(Vs + row_ * VPITCH + col_ * 16) = vreg[i_]; } } while (0)
    LAS unsigned* dflag = (LAS unsigned*)(lds + 40960);
    bool wdead = false;
    if (lane == 0) dflag[wave] = 0u;
    SB_LOAD(ntiles - 1);
    for (int kt = ntiles - 1; kt >= 0; --kt) {
        LDS_BARRIER();
        { unsigned nd = 0u;
#pragma unroll
          for (int w = 0; w < 8; ++w) nd += dflag[w];
          if (nd == 8u) break; }
        SB_STORE();
        LDS_BARRIER();
        if (kt > 0) SB_LOAD(kt - 1);
        if (kt * 64 <= tq0 && !wdead) {
            const int t = tq0 + r;
#pragma unroll
            for (int hf = 1; hf >= 0; --hf) {
                f32x16 acc;
#pragma unroll
                for (int i = 0; i < 16; ++i) acc[i] = 0.f;
#pragma unroll
                for (int ks = 0; ks < 8; ++ks) { const bf16x8 a = *(const LAS bf16x8*)(Ks + (32 * hf + r) * KP + (16 * ks + 8 * hh) * 2); acc = MFMA32(a, qf[ks], acc); }
                const int sbase = kt * 64 + 32 * hf + 4 * hh;
                float lk[16];
#pragma unroll
                for (int i = 0; i < 16; ++i) {
                    const float z = acc[i] * scale;
                    const bool valid = (sbase + (i & 3) + 8 * (i >> 2)) < t;
                    const float e = fexp2(-fabsf(z) * LOG2E);
                    const float sp = fmaxf(z, 0.f) + flog2(1.0f + e) * LN2;
                    lk[i] = valid ? -sp : 0.f;
                    acc[i] = z;
                }
                float G[4], PT[4], GP[4];
#pragma unroll
                for (int g = 0; g < 4; ++g) {
                    G[g] = (lk[4 * g] + lk[4 * g + 1]) + (lk[4 * g + 2] + lk[4 * g + 3]);
                    auto rr = __builtin_amdgcn_permlane32_swap(__float_as_uint(G[g]), __float_as_uint(G[g]), false, false);
                    const float lo = __uint_as_float(rr[0]), up = __uint_as_float(rr[1]);
                    PT[g] = lo + up; GP[g] = hh ? lo : up;
                }
                float running = carry;
#pragma unroll
                for (int g = 3; g >= 0; --g) {
                    const float off = running + (hh == 0 ? GP[g] : 0.f);
                    const float c3 = off + lk[4 * g + 3], c2 = c3 + lk[4 * g + 2], c1 = c2 + lk[4 * g + 1], c0 = c1 + lk[4 * g];
                    acc[4 * g + 3] = ((sbase + 3 + 8 * g) < t) ? fexp2((acc[4 * g + 3] + c3) * LOG2E) : 0.f;
                    acc[4 * g + 2] = ((sbase + 2 + 8 * g) < t) ? fexp2((acc[4 * g + 2] + c2) * LOG2E) : 0.f;
                    acc[4 * g + 1] = ((sbase + 1 + 8 * g) < t) ? fexp2((acc[4 * g + 1] + c1) * LOG2E) : 0.f;
                    acc[4 * g + 0] = ((sbase + 0 + 8 * g) < t) ? fexp2((acc[4 * g + 0] + c0) * LOG2E) : 0.f;
                    running += PT[g];
                }
                carry = running;
#pragma unroll
                for (int ks2 = 0; ks2 < 2; ++ks2) { const bf16x8 pb = pack8(acc, ks2); pv_step(o, Vs, pb, hf, ks2, lane); }
            }
            if (__all(carry < -SB_DEAD)) { wdead = true; if (lane == 0) dflag[wave] = 1u; }
        }
    }
#undef SB_LOAD
#undef SB_STORE
    out_norm_store(o, 1.0f, MIX + (tok0 + tq0 + r) * DM + 512 + h * 128, hh);
}

DI void mla_item(LAS unsigned char* lds, const bf16_t* P, const bf16_t* Q, const bf16_t* KV, bf16_t* MIX, int b, int h, int qb, int wave_) {
    const int tid = wave_ * 64 + lane_id();
    const int lane = tid & 63, wave = wave_, r = lane & 31, hh = lane >> 5;
    const size_t tok0 = (size_t)b * SEQ;
    const int tq0 = qb * 256 + wave * 32;
    constexpr int KP = 400;
    LAS unsigned char* Ks = lds; LAS unsigned char* Vs = lds + 64 * KP;
    bf16x8 qf[12];
    { const bf16_t* qp = Q + (tok0 + tq0 + r) * NQ + h * 192 + hh * 8;
#pragma unroll
      for (int ks = 0; ks < 12; ++ks) qf[ks] = *(const bf16x8*)(qp + ks * 16); }
    f32x16 o[4];
#pragma unroll
    for (int db = 0; db < 4; ++db)
#pragma unroll
        for (int i = 0; i < 16; ++i) o[db][i] = 0.f;
    float m_run = -1e30f, l_run = 0.f;
    const int ntiles = 4 * qb + 4;
    const float C = 0.07216878364870322f * LOG2E;
    u32x4 kreg[2], vreg[2], rreg;
    const bf16_t* kbase = KV + tok0 * NKV + h * 256;
    const bf16_t* rbase = P + tok0 * PP + C_KR;
#define ML_LOAD(kt) do { _Pragma("unroll") for (int i_ = 0; i_ < 2; ++i_) { const int c_ = tid + 512 * i_, row_ = c_ >> 4, col_ = c_ & 15; \
        const size_t go_ = (size_t)((kt) * 64 + row_) * NKV + col_ * 8; kreg[i_] = *(const u32x4*)(kbase + go_); vreg[i_] = *(const u32x4*)(kbase + go_ + 128); } \
        rreg = *(const u32x4*)(rbase + (size_t)((kt) * 64 + (tid >> 3)) * PP + (tid & 7) * 8); } while (0)
#define ML_STORE() do { _Pragma("unroll") for (int i_ = 0; i_ < 2; ++i_) { const int c_ = tid + 512 * i_, row_ = c_ >> 4, col_ = c_ & 15; \
        *(LAS u32x4*)(Ks + row_ * KP + col_ * 16) = kreg[i_]; *(LAS u32x4*)(Vs + row_ * VPITCH + col_ * 16) = vreg[i_]; } \
        *(LAS u32x4*)(Ks + (tid >> 3) * KP + 256 + (tid & 7) * 16) = rreg; } while (0)
    ML_LOAD(0);
    for (int kt = 0; kt < ntiles; ++kt) {
        LDS_BARRIER();
        ML_STORE();
        LDS_BARRIER();
        if (kt + 1 < ntiles) ML_LOAD(kt + 1);
        if (kt <= (tq0 >> 6)) {
            f32x16 s0, s1;
#pragma unroll
            for (int i = 0; i < 16; ++i) { s0[i] = 0.f; s1[i] = 0.f; }
            {
                const LAS unsigned char* k0p = Ks + r * KP + 16 * hh; const LAS unsigned char* k1p = k0p + 32 * KP;
                bf16x8 fa[2], fb[2], na[2], nb[2];
#pragma unroll
                for (int j = 0; j < 2; ++j) { fa[j] = *(const LAS bf16x8*)(k0p + 32 * j); fb[j] = *(const LAS bf16x8*)(k1p + 32 * j); }
#pragma unroll
                for (int g = 0; g < 6; ++g) {
                    if (g < 5) {
#pragma unroll
                        for (int j = 0; j < 2; ++j) { na[j] = *(const LAS bf16x8*)(k0p + 32 * (2 * g + 2 + j)); nb[j] = *(const LAS bf16x8*)(k1p + 32 * (2 * g + 2 + j)); }
                    }
#pragma unroll
                    for (int j = 0; j < 2; ++j) { s0 = MFMA32(fa[j], qf[2 * g + j], s0); s1 = MFMA32(fb[j], qf[2 * g + j], s1); }
                    if (g < 5) {
#pragma unroll
                        for (int j = 0; j < 2; ++j) { fa[j] = na[j]; fb[j] = nb[j]; }
                    }
                    __builtin_amdgcn_sched_barrier(0);
                }
            }
            float mx = s0[0];
#pragma unroll
            for (int i = 1; i < 16; ++i) mx = fmaxf(mx, s0[i]);
#pragma unroll
            for (int i = 0; i < 16; ++i) mx = fmaxf(mx, s1[i]);
            mx = pair_max(mx);
            const float mnew = fmaxf(m_run, mx);
            const float alpha = fexp2((m_run - mnew) * C);
            m_run = mnew;
            const float mc = -mnew * C;
            float ps = 0.f;
#pragma unroll
            for (int i = 0; i < 16; ++i) { s0[i] = fexp2(fmaf(s0[i], C, mc)); s1[i] = fexp2(fmaf(s1[i], C, mc)); ps += s0[i] + s1[i]; }
            ps = pair_sum(ps);
            l_run = l_run * alpha + ps;
            if (!__all(alpha == 1.0f)) {
#pragma unroll
            for (int db = 0; db < 4; ++db)
#pragma unroll
                for (int i = 0; i < 16; ++i) o[db][i] *= alpha;
            }
#pragma unroll
            for (int ks2 = 0; ks2 < 2; ++ks2) { const bf16x8 pb = pack8(s0, ks2); pv_step(o, Vs, pb, 0, ks2, lane); }
#pragma unroll
            for (int ks2 = 0; ks2 < 2; ++ks2) { const bf16x8 pb = pack8(s1, ks2); pv_step(o, Vs, pb, 1, ks2, lane); }
        }
    }
#undef ML_LOAD
#undef ML_STORE
    out_norm_store(o, 1.0f / l_run, MIX + (tok0 + tq0 + r) * DM + 1280 + h * 128, hh);
}

DI void hg_item(LAS unsigned char* lds, const bf16_t* P, bf16_t* MIX, const float* lbs, int layer, int b, int h, int wave_) {
    const int tid = wave_ * 64 + lane_id();
    const int lane = tid & 63, wave = wave_, r = lane & 31, hh = lane >> 5;
    const int k = tid & 127, tq = tid >> 7;
    constexpr int P128 = 272, P64 = 144;
    LAS unsigned char* Qt = lds; LAS unsigned char* Kt = lds + 17408; LAS unsigned char* Qg = lds + 34816;
    LAS unsigned char* KgT = lds + 52224; LAS unsigned char* VT = lds + 70656; LAS unsigned char* Am = lds + 89088; LAS unsigned char* ST = lds + 98304;
    LAS float* tot = (LAS float*)(lds + 133120); LAS float* dec = (LAS float*)(lds + 135168); LAS float* red = (LAS float*)(lds + 135680);
    float lb = 0.f;
    if (layer == 1) { const float a0 = lbs[h * 128 + k], a1 = lbs[512 + h * 128 + k]; lb = 1.0f / (1.0f + __expf(a0 - a1)); }
    const float oml = 1.0f - lb;
    const size_t tok0 = (size_t)b * SEQ;
    LDS_BARRIER();
    for (int i = tid; i < 34816 / 4; i += 512) ((LAS unsigned*)ST)[i] = 0u;
    f32x16 st[2];
#pragma unroll
    for (int j = 0; j < 2; ++j)
#pragma unroll
        for (int i = 0; i < 16; ++i) st[j][i] = 0.f;
    u32x4 rawq[2], rawf[2]; u32x4 vld[2]; u32x2 gpre[4];
    const bf16_t* qrow = P + tok0 * PP + C_HQ + h * 128;
    const bf16_t* vbase = P + tok0 * PP + C_HV + h * 128;
    const bf16_t* gbase = P + (tok0 + 32 * (wave >> 2) + r) * PP + C_HG + h * 128 + 32 * (wave & 3) + 4 * hh;
    u32x2 gnext[4];
#define HG_LOAD(c) do { _Pragma("unroll") for (int i_ = 0; i_ < 2; ++i_) { const int c_ = tid + 512 * i_; \
            { const int row_ = c_ >> 4, col_ = c_ & 15; const bf16_t* p_ = qrow + (size_t)((c) * 64 + row_) * PP + col_ * 8; rawq[i_] = *(const u32x4*)p_; rawf[i_] = *(const u32x4*)(p_ + 512); } \
            { const int s_ = c_ & 63, v0_ = (c_ >> 6) * 8; vld[i_] = *(const u32x4*)(vbase + (size_t)((c) * 64 + s_) * PP + v0_); } } \
        _Pragma("unroll") for (int g_ = 0; g_ < 4; ++g_) gnext[g_] = *(const u32x2*)(gbase + (size_t)((c) * 64) * PP + 8 * g_); } while (0)
    HG_LOAD(0);
    for (int c = 0; c < 32; ++c) {
#pragma unroll
        for (int g = 0; g < 4; ++g) gpre[g] = gnext[g];
#pragma unroll
        for (int i = 0; i < 2; ++i) { const int c_ = tid + 512 * i, row_ = c_ >> 4, col_ = c_ & 15;
            *(LAS u32x4*)(Qt + row_ * P128 + col_ * 16) = rawq[i]; *(LAS u32x4*)(Kt + row_ * P128 + col_ * 16) = rawf[i]; }
        LDS_BARRIER();
        for (int dupA = 0; dupA < HGA_REPS; ++dupA) {
        float lf[16], kk[16]; float cs = 0.f;
#pragma unroll
        for (int i = 0; i < 16; ++i) {
            const float fp = bf2f(*(const LAS unsigned short*)(Kt + (16 * tq + i) * P128 + k * 2));
            const float e = fexp2(-fp * LOG2E);
            const float sg = __builtin_amdgcn_rcpf(1.0f + e);
            const float sn = (e > 1e30f) ? 1.0f : e * sg;
            const float f = lb + oml * sg;
            cs += flog2(fmaxf(f, 1e-37f)) * LN2; lf[i] = cs; kk[i] = oml * sn;
        }
        tot[tq * 128 + k] = cs;
        LDS_BARRIER();
        const float t0 = tot[k], t1 = tot[128 + k], t2 = tot[256 + k], t3 = tot[384 + k];
        const float offs = (tq > 0 ? t0 : 0.f) + (tq > 1 ? t1 : 0.f) + (tq > 2 ? t2 : 0.f);
        const float gref = t0 + t1, gl = (t0 + t1) + (t2 + t3);
#pragma unroll
        for (int i = 0; i < 16; ++i) {
            const float g = offs + lf[i]; const int t = 16 * tq + i; const float qv = bf2f(*(const LAS unsigned short*)(Qt + t * P128 + k * 2));
            const float e1 = fexp2(fminf(g - gref, 80.f) * LOG2E), e2 = fexp2(g * LOG2E), e3 = fexp2(fminf(gref - g, 80.f) * LOG2E), e4 = fexp2((gl - g) * LOG2E);
            *(LAS unsigned short*)(Qt + t * P128 + k * 2) = (unsigned short)pk2(qv * e1, 0.f);
            *(LAS unsigned short*)(Qg + t * P128 + k * 2) = (unsigned short)pk2(qv * e2, 0.f);
            *(LAS unsigned short*)(Kt + t * P128 + k * 2) = (unsigned short)pk2(kk[i] * e3, 0.f);
            *(LAS unsigned short*)(KgT + k * P64 + t * 2) = (unsigned short)pk2(kk[i] * e4, 0.f);
        }
        if (tq == 0) dec[k] = fexp2(gl * LOG2E);
#pragma unroll
        for (int i = 0; i < 2; ++i) { const int c_ = tid + 512 * i, s_ = c_ & 63, v0_ = (c_ >> 6) * 8;
            const unsigned w[4] = {vld[i].x, vld[i].y, vld[i].z, vld[i].w};
#pragma unroll
            for (int j = 0; j < 4; ++j) { *(LAS unsigned short*)(VT + (v0_ + 2 * j) * P64 + s_ * 2) = (unsigned short)(w[j] & 0xffffu); *(LAS unsigned short*)(VT + (v0_ + 2 * j + 1) * P64 + s_ * 2) = (unsigned short)(w[j] >> 16); } }
        LDS_BARRIER();
        }
        if (c + 1 < 32) HG_LOAD(c + 1);
        if (wave < 4) {
            const int sb = wave & 1, tb = wave >> 1;
            f32x16 x;
#pragma unroll
            for (int i = 0; i < 16; ++i) x[i] = 0.f;
            if (sb <= tb) {
#pragma unroll
                for (int ks = 0; ks < 8; ++ks) { const bf16x8 a = *(const LAS bf16x8*)(Kt + (32 * sb + r) * P128 + (16 * ks + 8 * hh) * 2); const bf16x8 bq = *(const LAS bf16x8*)(Qt + (32 * tb + r) * P128 + (16 * ks + 8 * hh) * 2); x = MFMA32(a, bq, x); }
            }
            const int t = 32 * tb + r;
#pragma unroll
            for (int g = 0; g < 4; ++g) {
                float v[4];
#pragma unroll
                for (int j = 0; j < 4; ++j) { const int s = 32 * sb + 8 * g + 4 * hh + j; v[j] = (s <= t && sb <= tb) ? x[4 * g + j] : 0.f; }
                u32x2 w; w.x = pk2(v[0], v[1]); w.y = pk2(v[2], v[3]);
                *(LAS u32x2*)(Am + t * P64 + (32 * sb + 8 * g + 4 * hh) * 2) = w;
            }
        }
        LDS_BARRIER();
        const int vb = wave & 3, tb2 = wave >> 2;
        f32x16 acc;
#pragma unroll
        for (int i = 0; i < 16; ++i) acc[i] = 0.f;
#pragma unroll
        for (int ks = 0; ks < 4; ++ks) { const bf16x8 a = *(const LAS bf16x8*)(VT + (32 * vb + r) * P64 + (16 * ks + 8 * hh) * 2); const bf16x8 bb = *(const LAS bf16x8*)(Am + (32 * tb2 + r) * P64 + (16 * ks + 8 * hh) * 2); acc = MFMA32(a, bb, acc); }
#pragma unroll
        for (int ks = 0; ks < 8; ++ks) { const bf16x8 a = *(const LAS bf16x8*)(ST + (32 * vb + r) * P128 + (16 * ks + 8 * hh) * 2); const bf16x8 bb = *(const LAS bf16x8*)(Qg + (32 * tb2 + r) * P128 + (16 * ks + 8 * hh) * 2); acc = MFMA32(a, bb, acc); }
        const int kb = wave >> 1;
#pragma unroll
        for (int j = 0; j < 2; ++j) {
            const int vb2 = 2 * (wave & 1) + j;
#pragma unroll
            for (int i = 0; i < 16; ++i) st[j][i] *= dec[32 * kb + crow(i, hh)];
#pragma unroll
            for (int ks = 0; ks < 4; ++ks) { const bf16x8 a = *(const LAS bf16x8*)(KgT + (32 * kb + r) * P64 + (16 * ks + 8 * hh) * 2); const bf16x8 bb = *(const LAS bf16x8*)(VT + (32 * vb2 + r) * P64 + (16 * ks + 8 * hh) * 2); st[j] = MFMA32(a, bb, st[j]); }
        }
        { float ss = 0.f;
#pragma unroll
          for (int i = 0; i < 16; ++i) ss += acc[i] * acc[i];
          ss = pair_sum(ss);
          if (hh == 0) red[(32 * tb2 + r) * 4 + vb] = ss; }
        LDS_BARRIER();
#pragma unroll
        for (int j = 0; j < 2; ++j) { const int vb2 = 2 * (wave & 1) + j;
#pragma unroll
            for (int g = 0; g < 4; ++g) { u32x2 w; w.x = pk2(st[j][4 * g], st[j][4 * g + 1]); w.y = pk2(st[j][4 * g + 2], st[j][4 * g + 3]);
                *(LAS u32x2*)(ST + (32 * vb2 + r) * P128 + (32 * kb + 8 * g + 4 * hh) * 2) = w; } }
        { const int t = 32 * tb2 + r; const LAS float* rp = red + t * 4;
          const float ssq = (rp[0] + rp[1]) + (rp[2] + rp[3]);
          const float rs = rsqrtf(ssq * (1.0f / 128.0f) + EPS);
          const size_t tok = tok0 + c * 64 + t;
          bf16_t* op = MIX + tok * DM + h * 128 + 32 * vb + 4 * hh;
#pragma unroll
          for (int g = 0; g < 4; ++g) {
              const u32x2 gw = gpre[g];
              const float g0 = bflo(gw.x), g1 = bfhi(gw.x), g2 = bflo(gw.y), g3 = bfhi(gw.y);
              const float y0 = acc[4 * g] * rs * g0 * __builtin_amdgcn_rcpf(1.0f + fexp2(-g0 * LOG2E));
              const float y1 = acc[4 * g + 1] * rs * g1 * __builtin_amdgcn_rcpf(1.0f + fexp2(-g1 * LOG2E));
              const float y2 = acc[4 * g + 2] * rs * g2 * __builtin_amdgcn_rcpf(1.0f + fexp2(-g2 * LOG2E));
              const float y3 = acc[4 * g + 3] * rs * g3 * __builtin_amdgcn_rcpf(1.0f + fexp2(-g3 * LOG2E));
              u32x2 w; w.x = pk2(y0, y1); w.y = pk2(y2, y3);
              *(u32x2*)(op + 8 * g) = w;
          } }
    }
#undef HG_LOAD
    LDS_BARRIER();
}


#define XB_TMO      128
#define XB_XCNT(j)  (256  + 64 * (j))
#define XB_XSUB(j)  (1280 + 64 * (j))
#define XB_XGEN(j)  (2304 + 64 * (j))
#define XB_TOP      3328
#define XB_TOPGEN   3392
#define XCD_BAR_WORDS 3456
#define XB_SPIN_CAP (1u << 18)
DI unsigned xb_ld(unsigned* p)              { return __hip_atomic_load(p, __ATOMIC_RELAXED, __HIP_MEMORY_SCOPE_AGENT); }
DI unsigned xb_add(unsigned* p, unsigned v) { return __hip_atomic_fetch_add(p, v, __ATOMIC_RELAXED, __HIP_MEMORY_SCOPE_AGENT); }
DI unsigned xb_xcc_id() { return (unsigned)__builtin_amdgcn_s_getreg((3 << 11) | 20) & 0xFu; }
#define XB_SPIN(cond, bar) do { unsigned _sp = 0; while (cond) { __builtin_amdgcn_s_sleep(1); \
    if ((++_sp & 255u) == 0u) { if (xb_ld(&(bar)[XB_TMO])) break; if (_sp > XB_SPIN_CAP) { atomicAdd(&(bar)[XB_TMO], 1u); break; } } } } while (0)
DI void xcd_barrier_complete(unsigned* bar, unsigned x, unsigned& nloc, unsigned& nx, unsigned G) {
    unsigned sum, cnt, mine, sp = 0u;
    for (;;) {
        sum = 0u; cnt = 0u; mine = 0u;
#pragma unroll
        for (unsigned j = 0; j < 16; ++j) { const unsigned c = xb_ld(&bar[XB_XCNT(j)]); sum += c; cnt += (c > 0u) ? 1u : 0u; mine = (j == x) ? c : mine; }
        if (sum == G) break;
        __builtin_amdgcn_s_sleep(1);
        if ((++sp & 255u) == 0u) { if (xb_ld(&bar[XB_TMO])) break; if (sp > XB_SPIN_CAP) { atomicAdd(&bar[XB_TMO], 1u); break; } }
    }
    nloc = mine > 0u ? mine : 1u; nx = cnt > 0u ? cnt : 1u;
}
DI void xcd_barrier(unsigned* bar, volatile LAS unsigned* st, bool t0, unsigned total) {
    asm volatile("s_waitcnt vmcnt(0)" ::: "memory");
    LDS_BARRIER();
    if (t0) {
        const unsigned x = xb_xcc_id();
        __builtin_amdgcn_s_waitcnt(0);
        unsigned nloc = st[0], nx = st[1];
        if (nloc == 0u) { xcd_barrier_complete(bar, x, nloc, nx, total); st[0] = nloc; st[1] = nx; }
        const unsigned old = xb_add(&bar[XB_XSUB(x)], 1u);
        const unsigned gen = old / nloc;
        if (old + 1u == (gen + 1u) * nloc) {
            __builtin_amdgcn_fence(__ATOMIC_RELEASE, "agent");
            asm volatile("s_waitcnt vmcnt(0)" ::: "memory");
            const unsigned og = xb_add(&bar[XB_TOP], 1u);
            const unsigned tg = og / nx;
            if (og + 1u == (tg + 1u) * nx) xb_add(&bar[XB_TOPGEN], 1u);
            else XB_SPIN(xb_ld(&bar[XB_TOPGEN]) == tg, bar);
            __builtin_amdgcn_fence(__ATOMIC_ACQUIRE, "agent");
            xb_add(&bar[XB_XGEN(x)], 1u);
            asm volatile("s_waitcnt vmcnt(0)" ::: "memory");
        } else {
            XB_SPIN(xb_ld(&bar[XB_XGEN(x)]) == gen, bar);
            __builtin_amdgcn_fence(__ATOMIC_ACQUIRE, "agent");
            asm volatile("s_waitcnt vmcnt(0)" ::: "memory");
        }
    }
    LDS_BARRIER();
}
constexpr size_t CTL_BAR = 20 * 65536;
#ifndef USE_CG_SYNC
#define GBAR() xcd_barrier((unsigned*)(ARGS()->ws + WS_CTL + CTL_BAR), (volatile LAS unsigned*)(lds + LDS_QWORD + 16), (wave == 0 && lane_id() == 0), (unsigned)G)
#define SUBBAR() xcd_barrier((unsigned*)(ARGS()->ws + WS_CTL + CTL_BAR + 16384), (volatile LAS unsigned*)(lds + LDS_QWORD + 24), (wave == 0 && lane_id() == 0), (unsigned)(G - NHG))
constexpr int NHG = 32;
DI void xcc_local_barrier(unsigned* bar, bool t0, unsigned nloc) {
    asm volatile("" : "+s"(nloc));
    asm volatile("s_waitcnt vmcnt(0)" ::: "memory");
    __syncthreads();
    if (t0) {
        const unsigned x = xb_xcc_id();
        __builtin_amdgcn_s_waitcnt(0);
        const unsigned old = xb_add(&bar[XB_XSUB(x)], 1u);
        const unsigned gen = old / nloc;
        if (old + 1u == (gen + 1u) * nloc) xb_add(&bar[XB_XGEN(x)], 1u);
        else XB_SPIN(xb_ld(&bar[XB_XGEN(x)]) == gen, bar);
        __builtin_amdgcn_fence(__ATOMIC_ACQUIRE, "agent");
        asm volatile("s_waitcnt vmcnt(0)" ::: "memory");
    }
    __syncthreads();
}
#define VC_ID() (((volatile LAS unsigned*)(lds + LDS_QWORD + 32))[1] ? (int)__builtin_amdgcn_readfirstlane((int)((volatile LAS unsigned*)(lds + LDS_QWORD + 32))[0]) : (int)blockIdx.x)
#define LBAR() do { if (((volatile LAS unsigned*)(lds + LDS_QWORD + 32))[1]) xcc_local_barrier((unsigned*)(ARGS()->ws + WS_CTL + CTL_BAR + 32768), (wave == 0 && lane_id() == 0), (unsigned)(G / 8)); else GBAR(); } while (0)
#else
#define GBAR() grid.sync()
#endif

struct Args { const float* in[18]; const int* pos; float* out; unsigned char* ws; };

typedef const __attribute__((address_space(4))) Args* ArgsP;
#define ARGS() ({ ArgsP p_ = (ArgsP)__builtin_amdgcn_kernarg_segment_ptr(); asm volatile("" : "+s"(p_)); p_; })

#ifdef PROBE_I1
#define STAMP(k) do { if (blockIdx.x == 0 && wave == 0 && lane_id() == 0) { ArgsP sp_ = ARGS(); ((unsigned long long*)(sp_->ws + WS_CTL + 29 * 65536))[k] = __builtin_amdgcn_s_memrealtime(); } } while (0)
#else
#define STAMP(k) do { } while (0)
#endif
__global__ void __launch_bounds__(512, 2) mega(Args a_unused) {
    extern __shared__ __attribute__((aligned(16))) unsigned char lds_raw[];
    LAS unsigned char* lds = (LAS unsigned char*)lds_raw;
    cg::grid_group grid = cg::this_grid();
    const int wave = __builtin_amdgcn_readfirstlane((int)threadIdx.x >> 6) & 7;
    const int G = gridDim.x;
    const int vcu = (G % 8 == 0) ? ((int)blockIdx.x % 8) * (G / 8) + (int)blockIdx.x / 8 : (int)blockIdx.x;
    const int gw = vcu * 8 + wave, NGW = G * 8;
    if (wave == 0) { const int l0 = lane_id(); if (l0 < 8) ((LAS unsigned*)(lds + LDS_QWORD + 16))[l0] = 0u; }
    __syncthreads();
    STAMP(0);

    for (int l = 0; l < 2; ++l) {
        for (int stage = l; stage < 2; ++stage) {
            if (stage == 1) {
            {
                ArgsP ap = ARGS(); unsigned char* ws = ap->ws; ssq_t* ssq = (ssq_t*)(ws + WS_CTL);
                pg8::Gemm g{(const bf16_t*)(ws + WS_XB), (const bf16_t*)(ws + WS_WL + (size_t)l * WL_SIZE + WL_IN), M, NINP, DM, DM}; pg8::StaticOrder S; S.init(M, 5120, G, VC_ID());
                EpiIn E{(bf16_t*)(ws + WS_BIG), ssq + (SSQ_IN0 + l) * 16384, ssq + (SSQ_Q0 + l) * 16384, ssq + (SSQ_KV0 + l) * 16384, ap->pos};
                pg8::gemm_phase<EpiIn, true>(lds, g, S, E, wave);
    #ifdef P1_DUP
                { EpiIn E2 = E; E2.ssq_q = (ssq_t*)(ws + WS_CTL + 22 * 65536); E2.ssq_kv = (ssq_t*)(ws + WS_CTL + 24 * 65536); pg8::gemm_phase<EpiIn>(lds, g, S, E2, wave); }
    #endif
            }
            }
            ArgsP ap = ARGS(); unsigned char* ws = ap->ws;
            int llane = lane_id(); asm volatile("" : "+v"(llane));
            const int ltid = wave * 64 + llane;
            const int ntot = (stage == 0) ? 7552 : ((l == 0) ? 2816 : 2048);
            unsigned* cq = (unsigned*)(ws + WS_CTL + CTL_QCTR) + 16 + l;
            int ngw_w = NGW; asm volatile("" : "+s"(ngw_w));
            for (int wrep = 0; wrep < W_REPS; ++wrep)
            for (int it = (stage == 0) ? gw : 0;; ) {
                if (stage == 1) { int t_ = 0; if (llane == 0) t_ = (int)atomicAdd(cq, 1u); it = __builtin_amdgcn_readfirstlane(t_); }
                if (it >= ntot) break;
                int gi;
                if (stage == 0) gi = (it < 3328) ? it : it + 640;
                else if (l == 0) gi = 8192 + it;
                else gi = (it < 640) ? 3328 + it : 11008 + (it - 640);
                int j, base;
                if (gi < 1984) { if (gi < 1344) { j = 0; base = 0; } else if (gi < 1424) { j = 1; base = 1344; } else if (gi < 1472) { j = 2; base = 1424; } else { j = 3; base = 1472; } }
                else if (gi < 3968) { if (gi < 3328) { j = 4; base = 1984; } else if (gi < 3408) { j = 5; base = 3328; } else if (gi < 3456) { j = 6; base = 3408; } else { j = 7; base = 3456; } }
                else if (gi < 6784) { j = 8; base = 3968; } else if (gi < 8192) { j = 9; base = 6784; } else if (gi < 11008) { j = 10; base = 8192; } else { j = 11; base = 11008; }
                WJob J;
                const int jl = (j < 8) ? (j >> 2) : (j - 8) >> 1, jt = (j < 8) ? (j & 3) : 4 + ((j - 8) & 1);
                unsigned char* wlj = ws + WS_WL + (size_t)jl * WL_SIZE;
                J.W2 = nullptr; J.g2 = nullptr; J.g3 = nullptr;
                if (jt == 0) { J.W = ap->in[3] + (size_t)jl * DM * NIN; J.ldw = NIN; J.K = DM; J.nrows = NINP; J.mode = 1; J.g1 = ap->in[2] + jl * DM; J.b1 = DM; J.b2 = DM; J.WT = (bf16_t*)(wlj + WL_IN); }
                else if (jt == 1) { J.W = ap->in[8] + (size_t)jl * 512 * NQ; J.ldw = NQ; J.K = 512; J.nrows = NQP; J.mode = 2; J.g1 = ap->in[7] + jl * 512; J.b1 = 512; J.b2 = 512; J.WT = (bf16_t*)(wlj + WL_UQ); }
                else if (jt == 2) { J.W = ap->in[10] + (size_t)jl * 256 * NKV; J.ldw = NKV; J.K = 256; J.nrows = NKV; J.mode = 0; J.g1 = ap->in[9] + jl * 256; J.b1 = 256; J.b2 = 256; J.WT = (bf16_t*)(wlj + WL_UKV); }
                else if (jt == 3) { J.W = ap->in[12] + (size_t)jl * DM * DM; J.ldw = DM; J.K = DM; J.nrows = DM; J.mode = 0; J.g1 = ap->in[5] + jl * 512; J.g2 = ap->in[6] + jl * 768; J.g3 = ap->in[11] + jl * 768; J.b1 = 512; J.b2 = 1280; J.WT = (bf16_t*)(wlj + WL_O); }
                else if (jt == 4) { J.W = ap->in[14] + (size_t)jl * DM * DFF; J.W2 = ap->in[15] + (size_t)jl * DM * DFF; J.ldw = DFF; J.K = DM; J.nrows = 2 * DFF; J.mode = 3; J.g1 = ap->in[13] + jl * DM; J.b1 = DM; J.b2 = DM; J.WT = (jl == 0) ? (bf16_t*)(ws + WS_WGU) : (bf16_t*)((unsigned char*)ap->out + DO_WGU1); }
                else { J.W = ap->in[16] + (size_t)jl * DFF * DM; J.ldw = DM; J.K = DFF; J.nrows = DM; J.mode = 0; J.g1 = nullptr; J.b1 = 0; J.b2 = 0; J.WT = (jl == 0) ? (bf16_t*)(ws + WS_WDN) : (bf16_t*)((unsigned char*)ap->out + DO_WDN1); }
                wjob_item(J, gi - base, llane);
                if (stage == 0) it += ngw_w;
            }
            if (stage == 0) {
                ssq_t* ssq = (ssq_t*)(ws + WS_CTL); unsigned* qctr = (unsigned*)(ws + WS_CTL + CTL_QCTR);
                const float* x_in = ap->in[0]; bf16_t* XB = (bf16_t*)(ws + WS_XB);
                int zstride = G * 512, ngw = NGW; asm volatile("" : "+s"(zstride), "+s"(ngw));
                ssq_t zero64 = 0ull; asm volatile("" : "+v"(zero64));
                for (int i = (int)blockIdx.x * 512 + ltid; i < (SSQ_N - 1) * 16384; i += zstride) ssq[16384 + i] = zero64;
                if (blockIdx.x == 0 && ltid < 64) qctr[ltid] = 0u;
                if (blockIdx.x == 1) { unsigned* bw = (unsigned*)(ws + WS_CTL + CTL_BAR); for (int i = ltid; i < 16384; i += 512) bw[i] = 0u; }
                for (int m = gw; m < M; m += ngw) {
                    const f32x4* xr = (const f32x4*)(x_in + (size_t)m * DM) + llane;
                    u32x2* o8 = (u32x2*)(XB + (size_t)m * DM) + llane;
                    float s = 0.f;
#pragma unroll
                    for (int jj = 0; jj < 8; ++jj) { const f32x4 v = xr[64 * jj]; s += (v.x * v.x + v.y * v.y) + (v.z * v.z + v.w * v.w); u32x2 w; w.x = pk2(v.x, v.y); w.y = pk2(v.z, v.w); o8[64 * jj] = w; }
                    s = wave_sum64(s);
                    if (llane == 0) ssq[SSQ_IN0 * 16384 + m] = (ssq_t)(s * 16777216.0f);
                }
                grid.sync();
                if (wave == 0 && lane_id() == 0) { const unsigned xcc_ = xb_xcc_id(); const unsigned rank_ = xb_add(&((unsigned*)(ws + WS_CTL + CTL_BAR))[XB_XCNT(xcc_)], 1u);
                    ((volatile LAS unsigned*)(lds + LDS_QWORD + 32))[0] = xcc_ + 8u * rank_;
                    if ((int)blockIdx.x >= NHG) (void)xb_add(&((unsigned*)(ws + WS_CTL + CTL_BAR + 16384))[XB_XCNT(xb_xcc_id())], 1u); }
                STAMP(1);
            }
        }
        GBAR();
        if (l == 0) {
            if (wave == 0 && lane_id() == 0) { unsigned* bw_ = (unsigned*)(ARGS()->ws + WS_CTL + CTL_BAR); unsigned ok_ = ((G & 7) == 0) ? 1u : 0u;
                for (unsigned j = 0; j < 8; ++j) ok_ &= (xb_ld(&bw_[XB_XCNT(j)]) == (unsigned)(G / 8)) ? 1u : 0u;
                ((volatile LAS unsigned*)(lds + LDS_QWORD + 32))[1] = ok_; }
            __syncthreads();
        }
        STAMP(2 + 6 * l + 0);
        {
            const unsigned aff = (unsigned)__builtin_amdgcn_readfirstlane((int)((volatile LAS unsigned*)(lds + LDS_QWORD + 32))[1]);
            const int vcid = VC_ID();
            int is_hg, hb, hhd, cq_, ckv_, xcc_; bool do_kv = true; int gkv = G - NHG;
            if (aff) { const int rank = vcid >> 3; xcc_ = vcid & 7; is_hg = rank < 4; hb = xcc_; hhd = rank & 3; cq_ = (xcc_ + 8 * (rank - 4)) & 0xffff; ckv_ = (xcc_ + 8 * (rank - 16)) & 0xffff; do_kv = (rank >= 16); gkv = (G - NHG) - 12 * 8; }
            else { int bid = (int)blockIdx.x; asm volatile("" : "+s"(bid)); xcc_ = 0; is_hg = bid < NHG; hb = bid >> 2; hhd = bid & 3; cq_ = (bid - NHG) & 0xffff; ckv_ = (G - 1 - bid) & 0xffff; }
            unsigned mygen = 0u;
            if (is_hg) {
                ArgsP ap = ARGS(); unsigned char* ws = ap->ws;
                hg_item(lds, (const bf16_t*)(ws + WS_BIG), (bf16_t*)(ws + WS_MIX), ap->in[4], l, hb, hhd, wave);
            } else {
                {
                    ArgsP ap = ARGS(); unsigned char* ws = ap->ws; ssq_t* ssq = (ssq_t*)(ws + WS_CTL);
                    pg8::Gemm g{(const bf16_t*)(ws + WS_BIG) + C_CQ, (const bf16_t*)(ws + WS_WL + (size_t)l * WL_SIZE + WL_UQ), M, NQP, 512, PP}; pg8::StaticOrder S; S.init(M, NQP, G - NHG, cq_);
                    EpiQ E{(bf16_t*)ap->out, ssq + (SSQ_Q0 + l) * 16384, ap->pos};
                    for (int rep = 0; rep < P2_REPS; ++rep) pg8::gemm_phase<EpiQ>(lds, g, S, E, wave);
                }
                {
                    ArgsP ap = ARGS(); unsigned char* ws = ap->ws; ssq_t* ssq = (ssq_t*)(ws + WS_CTL);
                    pg8::Gemm g{(const bf16_t*)(ws + WS_BIG) + C_CKV, (const bf16_t*)(ws + WS_WL + (size_t)l * WL_SIZE + WL_UKV), M, NKV, 256, PP}; pg8::StaticOrder S; S.init(M, NKV, gkv, ckv_);
                    EpiKV E{(bf16_t*)(ws + WS_KV), ssq + (SSQ_KV0 + l) * 16384};
                    if (do_kv) pg8::gemm_phase<EpiKV>(lds, g, S, E, wave);
                }
                if (aff) {
                    asm volatile("s_waitcnt vmcnt(0)" ::: "memory");
                    __syncthreads();
                    if (wave == 0 && lane_id() == 0) { unsigned* b4 = (unsigned*)(ARGS()->ws + WS_CTL + CTL_BAR + 49152); unsigned nloc = (unsigned)((G - NHG) / 8); asm volatile("" : "+s"(nloc));
                        const unsigned old = xb_add(&b4[XB_XSUB(xcc_)], 1u); mygen = old / nloc;
                        if (old + 1u == (mygen + 1u) * nloc) xb_add(&b4[XB_XGEN(xcc_)], 1u); }
                } else SUBBAR();
                STAMP(2 + 6 * l + 1);
            }
            {
                ArgsP ap = ARGS(); unsigned char* ws = ap->ws;
                unsigned* qall = (unsigned*)(ws + WS_CTL + CTL_QCTR);
                unsigned* qmla = aff ? (qall + 32 + 16 * l + xcc_) : (qall + 4 * l);
                unsigned* qsb = aff ? (qall + 40 + 16 * l + xcc_) : (qall + 4 * l + 1);
                const int nitems = aff ? 48 : 384, per = aff ? 6 : 48;
                const bf16_t* Pb = (const bf16_t*)(ws + WS_BIG); const bf16_t* MQ = (const bf16_t*)ap->out; const bf16_t* KVb = (const bf16_t*)(ws + WS_KV); bf16_t* MIX = (bf16_t*)(ws + WS_MIX);
                LAS unsigned* qw = (LAS unsigned*)(lds + LDS_QWORD);
                bool waiting = (!is_hg) && (aff != 0u);
                bool mla_open = (!is_hg) && (aff == 0u);
                for (;;) {
                    __syncthreads();
                    if (wave == 0 && lane_id() == 0) {
                        unsigned go = 0u;
                        if (waiting) { unsigned* b4 = (unsigned*)(ws + WS_CTL + CTL_BAR + 49152);
                            go = (xb_ld(&b4[XB_XGEN(xcc_)]) != mygen) ? 1u : 0u;
                            if (go) { __builtin_amdgcn_fence(__ATOMIC_ACQUIRE, "agent"); asm volatile("s_waitcnt vmcnt(0)" ::: "memory"); } }
                        const bool take_mla = waiting ? (go != 0u) : mla_open;
                        qw[0] = atomicAdd(take_mla ? qmla : qsb, 1u); qw[1] = go;
                    }
                    __syncthreads();
                    const int item = (int)qw[0];
                    if (waiting && qw[1]) { waiting = false; mla_open = true; }
                    if (item >= nitems) {
                        if (waiting) { __builtin_amdgcn_s_sleep(8); continue; }
                        if (mla_open) { mla_open = false; continue; }
                        break;
                    }
                    const int qb = 7 - item / per, rem = item % per, bb = aff ? xcc_ : rem / 6, hd = rem % 6;
                    if (mla_open) mla_item(lds, Pb, MQ, KVb, MIX, bb, hd, qb, wave); else sb_item(lds, Pb, MIX, bb, hd, qb, wave);
                }
            }
        }
        LBAR();
        STAMP(2 + 6 * l + 2);
        {
            ArgsP ap = ARGS(); unsigned char* ws = ap->ws; ssq_t* ssq = (ssq_t*)(ws + WS_CTL);
            pg8::Gemm g{(const bf16_t*)(ws + WS_MIX), (const bf16_t*)(ws + WS_WL + (size_t)l * WL_SIZE + WL_O), M, DM, DM, DM}; pg8::StaticOrder S; S.init(M, DM, G, VC_ID());
            EpiRes E{(bf16_t*)(ws + WS_XB), ssq + (SSQ_F0 + l) * 16384};
            pg8::gemm_phase<EpiRes>(lds, g, S, E, wave);
        }
        LBAR();
        STAMP(2 + 6 * l + 3);
        {
            ArgsP ap = ARGS(); unsigned char* ws = ap->ws; ssq_t* ssq = (ssq_t*)(ws + WS_CTL);
            pg8::Gemm g{(const bf16_t*)(ws + WS_XB), (l == 0) ? (const bf16_t*)(ws + WS_WGU) : (const bf16_t*)((const unsigned char*)ap->out + DO_WGU1), M, 2 * DFF, DM, DM}; pg8::StaticOrder S; S.init(M, 2 * DFF, G, VC_ID(), 8);
            EpiGU E{(bf16_t*)(ws + WS_BIG), ssq + (SSQ_F0 + l) * 16384};
            pg8::gemm_phase<EpiGU>(lds, g, S, E, wave);
#ifdef PROBE_NOEPI
            { EpiNone EN{(float*)(ws + WS_CTL + 31 * 65536)}; pg8::gemm_phase<EpiNone>(lds, g, S, EN, wave); }
#endif
        }
        LBAR();
        STAMP(2 + 6 * l + 4);
        {
            ArgsP ap = ARGS(); unsigned char* ws = ap->ws; ssq_t* ssq = (ssq_t*)(ws + WS_CTL);
            pg8::Gemm g{(const bf16_t*)(ws + WS_BIG), (l == 0) ? (const bf16_t*)(ws + WS_WDN) : (const bf16_t*)((const unsigned char*)ap->out + DO_WDN1), M, DM, DFF, DFF}; pg8::StaticOrder S; S.init(M, DM, G, VC_ID());
            EpiRes E{(bf16_t*)(ws + WS_XB), ssq + ((l == 0) ? SSQ_IN1 : SSQ_FIN) * 16384};
            pg8::gemm_phase<EpiRes>(lds, g, S, E, wave);
        }
        if (l == 0) LBAR(); else GBAR();
        STAMP(2 + 6 * l + 5);
    }
#ifdef PROBE_SYNC
    for (int i = 0; i < 20; ++i) grid.sync();
#endif
    {
        ArgsP ap = ARGS(); const ssq_t* ssq = (const ssq_t*)(ap->ws + WS_CTL);
        const float* gf = ap->in[17]; float* out = ap->out; const bf16_t* XB = (const bf16_t*)(ap->ws + WS_XB);
        int lane = lane_id(); asm volatile("" : "+v"(lane));
        int ngw = NGW; asm volatile("" : "+s"(ngw));
        for (int m = gw; m < M; m += ngw) {
            const u32x4* xi = (const u32x4*)(XB + (size_t)m * DM) + lane;
            f32x4* o = (f32x4*)(out + (size_t)m * DM) + 2 * lane;
            const float rs = rsqrtf(ssq_get(ssq + SSQ_FIN * 16384, m) * (1.0f / DM) + EPS);
#pragma unroll
            for (int j = 0; j < 4; ++j) {
                const u32x4 w = xi[64 * j];
                const f32x4 g0 = ((const f32x4*)gf)[2 * lane + 128 * j], g1 = ((const f32x4*)gf)[2 * lane + 128 * j + 1];
                o[128 * j] = (f32x4){bflo(w.x), bfhi(w.x), bflo(w.y), bfhi(w.y)} * rs * g0;
                o[128 * j + 1] = (f32x4){bflo(w.z), bfhi(w.z), bflo(w.w), bfhi(w.w)} * rs * g1;
            }
        }
    }
#ifdef PROBE_I1
    grid.sync();
    STAMP(14);
    if (blockIdx.x == 0) {
        ArgsP ap = ARGS(); const unsigned long long* st = (const unsigned long long*)(ap->ws + WS_CTL + 29 * 65536);
        __syncthreads();
        const float T1 = (float)(st[PROBE_I1 + 1] - st[PROBE_I1]) * 0.01f, T2 = (float)(st[PROBE_I2 + 1] - st[PROBE_I2]) * 0.01f;
        const int n2 = (int)T2; const float V = T1 * 1000.0f;
        for (int j = wave * 64 + lane_id(); j < n2; j += 512) ap->out[j] = V;
    }
#endif
}

extern "C" void kernel_launch(void* const* d_in, const int* in_sizes, int n_in, void* d_out, int out_size, void* d_ws, size_t ws_size, hipStream_t stream) {
    static int grid = 0;
    if (grid == 0) {
        int dev = 0, cus = 0, per_cu = 0;
        (void)hipGetDevice(&dev);
        (void)hipDeviceGetAttribute(&cus, hipDeviceAttributeMultiprocessorCount, dev);
        (void)hipFuncSetAttribute((const void*)mega, hipFuncAttributeMaxDynamicSharedMemorySize, LDS_BYTES);
        (void)hipOccupancyMaxActiveBlocksPerMultiprocessor(&per_cu, (const void*)mega, 512, LDS_BYTES);
        grid = cus > 0 ? cus : 256;
        if (ws_size < WS_END) { fprintf(stderr, "kernel_launch: workspace too small: %zu < %zu\n", ws_size, (size_t)WS_END); grid = -1; }
        fprintf(stderr, "kernel_launch: cus %d per_cu %d grid %d ws %zu\n", cus, per_cu, grid, ws_size);
    }
    if (grid < 0) return;
    Args a{};
    for (int i = 0; i < 18; ++i) a.in[i] = (const float*)d_in[i];
    a.pos = (const int*)d_in[1];
    a.out = (float*)d_out; a.ws = (unsigned char*)d_ws;
    void* args[] = {&a};
    hipError_t e = hipLaunchCooperativeKernel((const void*)mega, dim3(grid), dim3(512), args, LDS_BYTES, stream);
    if (e != hipSuccess) fprintf(stderr, "cooperative launch failed: %s\n", hipGetErrorString(e));
}
```

```cpp
#include <hip/hip_runtime.h>
#include <hip/hip_cooperative_groups.h>
#include <cstdio>
namespace cg = cooperative_groups;

#define LAS __attribute__((address_space(3)))
typedef unsigned short bf16_t;
typedef short bf16x8 __attribute__((ext_vector_type(8)));
typedef short s16x4 __attribute__((ext_vector_type(4)));
typedef float f32x4 __attribute__((ext_vector_type(4)));
typedef float f32x2 __attribute__((ext_vector_type(2)));
typedef float f32x16 __attribute__((ext_vector_type(16)));
typedef unsigned u32x4 __attribute__((ext_vector_type(4)));
typedef unsigned u32x2 __attribute__((ext_vector_type(2)));
typedef __bf16 bf16x2n __attribute__((ext_vector_type(2)));
#define DI __device__ __forceinline__
#define MFMA32(a, b, c) __builtin_amdgcn_mfma_f32_32x32x16_bf16((a), (b), (c), 0, 0, 0)

constexpr int M = 16384, DM = 2048, SEQ = 2048, NB = 8;
constexpr int NIN = 5184, NINP = 5376, DFF = 5632;
constexpr int PP = 5632;
constexpr int C_HQ = 0, C_HF = 512, C_HV = 1024, C_HG = 1536, C_SQ = 2048, C_SK = 2816, C_SV = 3584, C_CQ = 4352, C_CKV = 4864, C_KR = 5120;
constexpr int NQ = 1152, NQP = 1280, NKV = 1536;
constexpr float EPS = 1e-6f;
constexpr float LOG2E = 1.4426950408889634f, LN2 = 0.6931471805599453f;

constexpr size_t MiB = 1u << 20;
constexpr size_t WS_CTL = 0;
constexpr size_t WS_WL = 2 * MiB;
constexpr size_t WL_IN = 0, WL_UQ = 21 * MiB, WL_UKV = WL_UQ + 1310720, WL_O = 23 * MiB, WL_SIZE = 31 * MiB;
constexpr size_t WS_WGU = 64 * MiB, WS_WDN = 108 * MiB;
constexpr size_t WS_XB = 130 * MiB;
constexpr size_t WS_BIG = 194 * MiB;
constexpr size_t WS_MIX = 370 * MiB;
constexpr size_t WS_KV = 434 * MiB;
constexpr size_t WS_END = 482 * MiB;
constexpr size_t DO_WGU1 = 40 * MiB, DO_WDN1 = 84 * MiB;
enum { SSQ_IN0 = 0, SSQ_IN1, SSQ_Q0, SSQ_Q1, SSQ_KV0, SSQ_KV1, SSQ_F0, SSQ_F1, SSQ_FIN, SSQ_N };
constexpr size_t CTL_QCTR = 30 * 65536;
typedef unsigned long long ssq_t;
DI float ssq_get(const ssq_t* p, int row) { return (float)p[row] * (1.0f / 16777216.0f); }
DI void ssq_add(ssq_t* p, int row, float s) { atomicAdd(p + row, (ssq_t)(s * 16777216.0f)); }

constexpr int LDS_BYTES = 139264;
constexpr int LDS_QWORD = 136704;
#ifndef GU_REPS
#define GU_REPS 1
#endif
#ifndef W_REPS
#define W_REPS 1
#endif
#ifndef P2_REPS
#define P2_REPS 1
#endif
#ifndef HGA_REPS
#define HGA_REPS 1
#endif
#ifndef MIX_REPS
#define MIX_REPS 1
#endif

DI int lane_id() { int l; asm volatile("v_mbcnt_lo_u32_b32 %0, -1, 0\n\tv_mbcnt_hi_u32_b32 %0, -1, %0" : "=v"(l)); return l; }
DI unsigned pk2(float a, float b) { f32x2 v = {a, b}; bf16x2n r = __builtin_convertvector(v, bf16x2n); return __builtin_bit_cast(unsigned, r); }
DI float bf2f(unsigned short u) { return __uint_as_float(((unsigned)u) << 16); }
DI float bflo(unsigned w) { return __uint_as_float(w << 16); }
DI float bfhi(unsigned w) { return __uint_as_float(w & 0xffff0000u); }
DI float fexp2(float x) { return __builtin_amdgcn_exp2f(x); }
DI float flog2(float x) { return __builtin_amdgcn_logf(x); }
DI float pair_sum(float v) { auto rr = __builtin_amdgcn_permlane32_swap(__float_as_uint(v), __float_as_uint(v), false, false); return __uint_as_float(rr[0]) + __uint_as_float(rr[1]); }
DI float pair_max(float v) { auto rr = __builtin_amdgcn_permlane32_swap(__float_as_uint(v), __float_as_uint(v), false, false); return fmaxf(__uint_as_float(rr[0]), __uint_as_float(rr[1])); }

namespace pg8 {
constexpr int BM = 256, BK = 64, HALF = 128, HTB = HALF * BK * 2, STAGE_BYTES = 8 * HTB, NXCD = 8, WGM = 4;
DI int lds_byte(int r, int c) { const int st = (r >> 4) * 2 + (c >> 5), rr = r & 15, cc = c & 31, ob = rr * 64 + cc * 2; return st * 1024 + (ob ^ (((ob >> 9) & 1) << 5)); }
DI void stage_rc(int b, int& R, int& C) { const int st = b / 1024, sb = b % 1024, swz = sb ^ (((sb >> 9) & 1) << 5); R = (st >> 1) * 16 + swz / 64; C = (st & 1) * 32 + (swz % 64) / 2; }
DI int perm32(int rho) { const int n = rho >> 4, i = rho & 15; return 8 * (i >> 2) + 4 * n + (i & 3); }
struct Unit { int pm, pn; };
struct Gemm { const bf16_t* A; const bf16_t* Bt; int M, N, K, lda; };
struct StaticOrder {
    int nM, nN, nwg, G, c, wgm;
    DI void init(int M_, int N_, int G_, int c_, int wgm_ = WGM) { nM = M_ / BM; nN = N_ / BM; nwg = nM * nN; G = G_; c = c_; wgm = wgm_; }
    DI bool next(int i, Unit& u) const {
        const long L = (long)i * G + c; if (L >= nwg) return false;
        int wgid = (int)L; { const int q = nwg / NXCD, r = nwg % NXCD, xcd = wgid % NXCD, off = wgid / NXCD; wgid = (xcd < r ? xcd * (q + 1) : r * (q + 1) + (xcd - r) * q) + off; }
        const int nig = wgm * nN, gid = wgid / nig, fm = gid * wgm, gsz = (nM - fm) < wgm ? (nM - fm) : wgm;
        u.pm = fm + ((wgid % nig) % gsz); u.pn = (wgid % nig) / gsz; return true;
    }
};
template <class Epi, bool TAIL20 = false>
DI void gemm_phase(LAS unsigned char* lds, const Gemm g, const StaticOrder& S_in, const Epi& E, int wid) {
    asm volatile("" : "+s"(wid));
    StaticOrder S = S_in; asm volatile("" : "+s"(S.c), "+s"(S.G));
    int lane = lane_id(); asm volatile("" : "+v"(lane));
    const int tid = wid * 64 + lane, wr = wid >> 2, wc = wid & 3, fr = lane & 15, fq = lane >> 4;
    const int K = g.K, nt = K / BK, lda = g.lda;
    unsigned voffA[2], voffB[2];
#pragma unroll
    for (int i = 0; i < 2; ++i) { int R, C; stage_rc(tid * 16 + i * 8192, R, C); const int Rb = (R & ~31) + perm32(R & 31);
        voffA[i] = (unsigned)(R * lda + C) * 2u; voffB[i] = (unsigned)(Rb * K + C) * 2u; }
    const size_t kstep = (size_t)(BK * 2);
    const size_t hstepA = (size_t)HALF * lda * 2, hstepB = (size_t)HALF * K * 2;
    const size_t tstepA = 2 * hstepA, tstepB = 2 * hstepB;
    const unsigned ldsw = (unsigned)wid * 1024u;
    const int aoff = lds_byte(wr * 64 + fr, fq * 8), boff = lds_byte(wc * 32 + fr, fq * 8);
#define PG8_SA(b, h) (((b) * 2 + (h)) * HTB)
#define PG8_SB(b, h) ((4 + (b) * 2 + (h)) * HTB)
#define PG8_STAGE(bufoff, gbase, voff) do { _Pragma("unroll") for (int _i = 0; _i < 2; ++_i) \
        __builtin_amdgcn_global_load_lds((const unsigned*)((const char*)(gbase) + (voff)[_i]), (LAS unsigned*)(lds + (bufoff) + ldsw + _i * 8192), 16, 0, 0); } while (0)
#define PG8_LDA(dst, b, h) do { _Pragma("unroll") for (int m = 0; m < 4; ++m) _Pragma("unroll") for (int k = 0; k < 2; ++k) dst[m][k] = *(const LAS bf16x8*)(lds + PG8_SA(b, h) + aoff + m * 2048 + k * 1024); } while (0)
#define PG8_LDB(dst, b, h) do { _Pragma("unroll") for (int n = 0; n < 2; ++n) _Pragma("unroll") for (int k = 0; k < 2; ++k) dst[n][k] = *(const LAS bf16x8*)(lds + PG8_SB(b, h) + boff + n * 2048 + k * 1024); } while (0)
#define PG8_MMA(ai, bj, At, Bt) do { __builtin_amdgcn_s_setprio(1); _Pragma("unroll") for (int m = 0; m < 4; ++m) _Pragma("unroll") for (int n = 0; n < 2; ++n) _Pragma("unroll") for (int k = 0; k < 2; ++k) \
        acc[ai][bj][m][n] = __builtin_amdgcn_mfma_f32_16x16x32_bf16(Bt[n][k], At[m][k], acc[ai][bj][m][n], 0, 0, 0); __builtin_amdgcn_s_setprio(0); } while (0)
#define PG8_WAIT_V(n) asm volatile("s_waitcnt vmcnt(" #n ")" ::: "memory")
#define PG8_WAIT_L(n) asm volatile("s_waitcnt lgkmcnt(" #n ")" ::: "memory")
#define PG8_BAR __builtin_amdgcn_s_barrier()
#define PG8_SCHED __builtin_amdgcn_sched_barrier(0)
#define PG8_KLOOP(MMAB1) \
        for (int t = 0; t < nt; t += 2) { \
            const bool last = (t == nt - 2); \
            const char* a1 = cA + (size_t)(t + 1) * kstep; \
            const char* a2 = last ? nA : cA + (size_t)(t + 2) * kstep; const char* b2 = last ? nB : cB + (size_t)(t + 2) * kstep; \
            const char* a3 = a2 + kstep; const char* b3 = b2 + kstep; \
            PG8_LDB(B0, 0, 0); PG8_SCHED; PG8_LDA(At, 0, 0); PG8_STAGE(PG8_SA(1, 1), a1 + hstepA, voffA); \
            PG8_WAIT_L(8); PG8_BAR; PG8_WAIT_L(0); PG8_MMA(0, 0, At, B0); PG8_BAR; PG8_SCHED; \
            PG8_LDB(B1, 0, 1); PG8_STAGE(PG8_SB(0, 0), b2, voffB); \
            PG8_BAR; PG8_WAIT_L(0); if (MMAB1) PG8_MMA(0, 1, At, B1); PG8_BAR; \
            PG8_LDA(At, 0, 1); PG8_STAGE(PG8_SA(0, 0), a2, voffA); \
            PG8_BAR; PG8_WAIT_L(0); PG8_MMA(1, 0, At, B0); PG8_BAR; PG8_SCHED; \
            PG8_STAGE(PG8_SB(0, 1), b2 + hstepB, voffB); \
            PG8_WAIT_V(6); PG8_BAR; if (MMAB1) PG8_MMA(1, 1, At, B1); PG8_BAR; \
            PG8_LDB(B0, 1, 0); PG8_SCHED; PG8_LDA(At, 1, 0); PG8_STAGE(PG8_SA(0, 1), a2 + hstepA, voffA); \
            PG8_WAIT_L(8); PG8_BAR; PG8_WAIT_L(0); PG8_MMA(0, 0, At, B0); PG8_BAR; PG8_SCHED; \
            PG8_LDB(B1, 1, 1); PG8_STAGE(PG8_SB(1, 0), b3, voffB); \
            PG8_BAR; PG8_WAIT_L(0); if (MMAB1) PG8_MMA(0, 1, At, B1); PG8_BAR; \
            PG8_LDA(At, 1, 1); PG8_STAGE(PG8_SA(1, 0), a3, voffA); \
            PG8_BAR; PG8_WAIT_L(0); PG8_MMA(1, 0, At, B0); PG8_BAR; PG8_SCHED; \
            PG8_STAGE(PG8_SB(1, 1), b3 + hstepB, voffB); \
            PG8_WAIT_V(6); PG8_BAR; if (MMAB1) PG8_MMA(1, 1, At, B1); PG8_BAR; \
        }
    Unit cur, nxt; int ui = 0;
#define PG8_NEXT(i, u) (TAIL20 ? (((i) < 5) ? S.next((i), (u)) : (((i) == 5 && S.c < 64) ? ((u).pm = S.c, (u).pn = 20, true) : false)) : S.next((i), (u)))
    if (!PG8_NEXT(0, cur)) return;
    f32x4 acc[2][2][4][2];
#pragma unroll
    for (int a = 0; a < 2; ++a)
#pragma unroll
        for (int b = 0; b < 2; ++b)
#pragma unroll
            for (int m = 0; m < 4; ++m)
#pragma unroll
                for (int n = 0; n < 2; ++n) acc[a][b][m][n] = (f32x4){0.f, 0.f, 0.f, 0.f};
    bf16x8 At[4][2], B0[2][2], B1[2][2];
    const char* cA = (const char*)g.A + (size_t)cur.pm * tstepA; const char* cB = (const char*)g.Bt + (size_t)cur.pn * tstepB;
    PG8_STAGE(PG8_SB(0, 0), cB, voffB); PG8_STAGE(PG8_SA(0, 0), cA, voffA); PG8_STAGE(PG8_SB(0, 1), cB + hstepB, voffB); PG8_STAGE(PG8_SA(0, 1), cA + hstepA, voffA);
    if (wr == 1) PG8_BAR;
    PG8_WAIT_V(4); PG8_BAR;
    PG8_STAGE(PG8_SB(1, 0), cB + kstep, voffB); PG8_STAGE(PG8_SA(1, 0), cA + kstep, voffA); PG8_STAGE(PG8_SB(1, 1), cB + hstepB + kstep, voffB);
    PG8_WAIT_V(6); PG8_BAR;
    for (;;) {
        const bool has_next = PG8_NEXT(ui + 1, nxt);
        const char* nA = has_next ? (const char*)g.A + (size_t)nxt.pm * tstepA : cA; const char* nB = has_next ? (const char*)g.Bt + (size_t)nxt.pn * tstepB : cB;
        if (TAIL20 && cur.pn == 20) { PG8_KLOOP(false) } else { PG8_KLOOP(true) }
        E(acc, cur, wr, wc, fr, fq);
        if (!has_next) break;
#pragma unroll
        for (int a = 0; a < 2; ++a)
#pragma unroll
            for (int b = 0; b < 2; ++b)
#pragma unroll
                for (int m = 0; m < 4; ++m)
#pragma unroll
                    for (int n = 0; n < 2; ++n) acc[a][b][m][n] = (f32x4){0.f, 0.f, 0.f, 0.f};
        cur = nxt; cA = nA; cB = nB; ++ui;
    }
    PG8_WAIT_V(0);
    if (wr == 0) PG8_BAR;
    PG8_BAR;
#undef PG8_KLOOP
#undef PG8_NEXT
#undef PG8_SA
#undef PG8_SB
#undef PG8_STAGE
#undef PG8_LDA
#undef PG8_LDB
#undef PG8_MMA
#undef PG8_WAIT_V
#undef PG8_WAIT_L
#undef PG8_BAR
#undef PG8_SCHED
}
}

typedef f32x4 AccT[2][2][4][2];

DI void rope8(f32x4& v0, f32x4& v1, int pos, int i0) {
    const float fp = (float)pos;
    float x[8] = {v0[0], v0[1], v0[2], v0[3], v1[0], v1[1], v1[2], v1[3]};
#pragma unroll
    for (int p = 0; p < 4; ++p) {
        const float invf = fexp2(-(float)(i0 + p) * 0.41524101186092029f);
        const float rev = __builtin_amdgcn_fractf(fp * invf * 0.15915494309189535f);
        const float sn = __builtin_amdgcn_sinf(rev), cs = __builtin_amdgcn_cosf(rev);
        const float x1 = x[2 * p], x2 = x[2 * p + 1];
        x[2 * p] = x1 * cs - x2 * sn; x[2 * p + 1] = x2 * cs + x1 * sn;
    }
    v0 = (f32x4){x[0], x[1], x[2], x[3]}; v1 = (f32x4){x[4], x[5], x[6], x[7]};
}
DI float quad_sum(float s) {
    auto r = __builtin_amdgcn_permlane16_swap(__float_as_uint(s), __float_as_uint(s), false, false);
    s = __uint_as_float(r[0]) + __uint_as_float(r[1]);
    return pair_sum(s);
}
#define DPP_ADD(s, ctrl) (s) += __uint_as_float((unsigned)__builtin_amdgcn_update_dpp(0, (int)__float_as_uint(s), (ctrl), 0xf, 0xf, true))
DI float wave_sum64(float s) {
    DPP_ADD(s, 0xB1); DPP_ADD(s, 0x4E);
    DPP_ADD(s, 0x141); DPP_ADD(s, 0x140);
    return quad_sum(s);
}

struct EpiIn {
    bf16_t* P; const ssq_t* ssq_in; ssq_t* ssq_q; ssq_t* ssq_kv; const int* pos;
    DI void operator()(const AccT& acc, const pg8::Unit& u, int wr, int wc, int fr, int fq) const {
        const int row0 = u.pm * 256 + wr * 64 + fr, col0 = u.pn * 256 + wc * 32 + 8 * fq;
        const bool do_rope = (u.pn == 20) && (wc < 2);
        ssq_t* ssq = (u.pn == 17 || u.pn == 18) ? ssq_q : (u.pn == 19 ? ssq_kv : nullptr);
        ssq_t raw[8];
#pragma unroll
        for (int i = 0; i < 8; ++i) raw[i] = ssq_in[row0 + (i >> 2) * 128 + (i & 3) * 16];
#pragma unroll
        for (int ai = 0; ai < 2; ++ai)
#pragma unroll
            for (int m = 0; m < 4; ++m) {
                const int row = row0 + ai * 128 + m * 16;
                const float sc = rsqrtf((float)raw[ai * 4 + m] * (1.0f / 16777216.0f) * (1.0f / DM) + EPS);
                float s = 0.f;
#pragma unroll
                for (int bj = 0; bj < 2; ++bj) {
                    f32x4 v0 = acc[ai][bj][m][0] * sc, v1 = acc[ai][bj][m][1] * sc;
                    if (do_rope && bj == 0) rope8(v0, v1, pos[row], 16 * wc + 4 * fq);
                    s += (v0[0] * v0[0] + v0[1] * v0[1]) + (v0[2] * v0[2] + v0[3] * v0[3]) + (v1[0] * v1[0] + v1[1] * v1[1]) + (v1[2] * v1[2] + v1[3] * v1[3]);
                    u32x4 w; w.x = pk2(v0[0], v0[1]); w.y = pk2(v0[2], v0[3]); w.z = pk2(v1[0], v1[1]); w.w = pk2(v1[2], v1[3]);
                    *(u32x4*)(P + (size_t)row * PP + col0 + bj * 128) = w;
                }
                if (ssq) { s = quad_sum(s); if (fq == 0) ssq_add(ssq, row, s); }
            }
    }
};
struct EpiQ {
    bf16_t* Q; const ssq_t* ssq_q; const int* pos;
    DI void operator()(const AccT& acc, const pg8::Unit& u, int wr, int wc, int fr, int fq) const {
        const int row0 = u.pm * 256 + wr * 64 + fr, col0 = u.pn * 256 + wc * 32 + 8 * fq;
        ssq_t raw[8];
#pragma unroll
        for (int i = 0; i < 8; ++i) raw[i] = ssq_q[row0 + (i >> 2) * 128 + (i & 3) * 16];
#pragma unroll
        for (int ai = 0; ai < 2; ++ai)
#pragma unroll
            for (int m = 0; m < 4; ++m) {
                const int row = row0 + ai * 128 + m * 16;
                const float sc = rsqrtf((float)raw[ai * 4 + m] * (1.0f / 16777216.0f) * (1.0f / 512.0f) + EPS);
                const int ps = pos[row];
#pragma unroll
                for (int bj = 0; bj < 2; ++bj) {
                    const int c = col0 + bj * 128;
                    if (c < NQ) {
                        f32x4 v0 = acc[ai][bj][m][0] * sc, v1 = acc[ai][bj][m][1] * sc;
                        const int within = c % 192;
                        if (within >= 128) rope8(v0, v1, ps, (within - 128) >> 1);
                        u32x4 w; w.x = pk2(v0[0], v0[1]); w.y = pk2(v0[2], v0[3]); w.z = pk2(v1[0], v1[1]); w.w = pk2(v1[2], v1[3]);
                        *(u32x4*)(Q + (size_t)row * NQ + c) = w;
                    }
                }
            }
    }
};
struct EpiKV {
    bf16_t* KV; const ssq_t* ssq_kv;
    DI void operator()(const AccT& acc, const pg8::Unit& u, int wr, int wc, int fr, int fq) const {
        const int row0 = u.pm * 256 + wr * 64 + fr, col0 = u.pn * 256 + wc * 32 + 8 * fq;
        ssq_t raw[8];
#pragma unroll
        for (int i = 0; i < 8; ++i) raw[i] = ssq_kv[row0 + (i >> 2) * 128 + (i & 3) * 16];
#pragma unroll
        for (int ai = 0; ai < 2; ++ai)
#pragma unroll
            for (int m = 0; m < 4; ++m) {
                const int row = row0 + ai * 128 + m * 16;
                const float sc = rsqrtf((float)raw[ai * 4 + m] * (1.0f / 16777216.0f) * (1.0f / 256.0f) + EPS);
#pragma unroll
                for (int bj = 0; bj < 2; ++bj) {
                    const f32x4 v0 = acc[ai][bj][m][0] * sc, v1 = acc[ai][bj][m][1] * sc;
                    u32x4 w; w.x = pk2(v0[0], v0[1]); w.y = pk2(v0[2], v0[3]); w.z = pk2(v1[0], v1[1]); w.w = pk2(v1[2], v1[3]);
                    *(u32x4*)(KV + (size_t)row * NKV + col0 + bj * 128) = w;
                }
            }
    }
};
struct EpiRes {
    bf16_t* XB; ssq_t* ssq_out;
    DI void operator()(const AccT& acc, const pg8::Unit& u, int wr, int wc, int fr, int fq) const {
        const int row0 = u.pm * 256 + wr * 64 + fr, col0 = u.pn * 256 + wc * 32 + 8 * fq;
#pragma unroll
        for (int ai = 0; ai < 2; ++ai) {
            u32x4 old[4][2];
#pragma unroll
            for (int m = 0; m < 4; ++m)
#pragma unroll
                for (int bj = 0; bj < 2; ++bj) old[m][bj] = *(const u32x4*)(XB + (size_t)(row0 + ai * 128 + m * 16) * DM + col0 + bj * 128);
#pragma unroll
            for (int m = 0; m < 4; ++m) {
                const int row = row0 + ai * 128 + m * 16;
                float s = 0.f;
#pragma unroll
                for (int bj = 0; bj < 2; ++bj) {
                    const size_t off = (size_t)row * DM + col0 + bj * 128;
                    const u32x4 o = old[m][bj];
                    const f32x4 v0 = acc[ai][bj][m][0] + (f32x4){bflo(o.x), bfhi(o.x), bflo(o.y), bfhi(o.y)};
                    const f32x4 v1 = acc[ai][bj][m][1] + (f32x4){bflo(o.z), bfhi(o.z), bflo(o.w), bfhi(o.w)};
                    s += (v0[0] * v0[0] + v0[1] * v0[1]) + (v0[2] * v0[2] + v0[3] * v0[3]) + (v1[0] * v1[0] + v1[1] * v1[1]) + (v1[2] * v1[2] + v1[3] * v1[3]);
                    u32x4 w; w.x = pk2(v0[0], v0[1]); w.y = pk2(v0[2], v0[3]); w.z = pk2(v1[0], v1[1]); w.w = pk2(v1[2], v1[3]);
                    *(u32x4*)(XB + off) = w;
                }
                s = quad_sum(s); if (fq == 0) ssq_add(ssq_out, row, s);
            }
            asm volatile("" ::: "memory");
        }
    }
};
struct EpiGU {
    bf16_t* H; const ssq_t* ssq_f;
    DI void operator()(const AccT& acc, const pg8::Unit& u, int wr, int wc, int fr, int fq) const {
        const int row0 = u.pm * 256 + wr * 64 + fr, col0 = u.pn * 128 + wc * 32 + 8 * fq;
        ssq_t raw[8];
#pragma unroll
        for (int i = 0; i < 8; ++i) raw[i] = ssq_f[row0 + (i >> 2) * 128 + (i & 3) * 16];
#pragma unroll
        for (int ai = 0; ai < 2; ++ai)
#pragma unroll
            for (int m = 0; m < 4; ++m) {
                const int row = row0 + ai * 128 + m * 16;
                const float sc = rsqrtf((float)raw[ai * 4 + m] * (1.0f / 16777216.0f) * (1.0f / DM) + EPS);
                float hv[8];
#pragma unroll
                for (int n = 0; n < 2; ++n)
#pragma unroll
                    for (int j = 0; j < 4; ++j) { const float gt = acc[ai][0][m][n][j] * sc, up = acc[ai][1][m][n][j] * sc;
                        hv[n * 4 + j] = gt * __builtin_amdgcn_rcpf(1.0f + fexp2(-gt * LOG2E)) * up; }
                u32x4 w; w.x = pk2(hv[0], hv[1]); w.y = pk2(hv[2], hv[3]); w.z = pk2(hv[4], hv[5]); w.w = pk2(hv[6], hv[7]);
                *(u32x4*)(H + (size_t)row * DFF + col0) = w;
            }
    }
};
struct EpiNone { float* sink; DI void operator()(const AccT& acc, const pg8::Unit& u, int wr, int wc, int fr, int fq) const { f32x4 t = {0.f, 0.f, 0.f, 0.f};
#pragma unroll
    for (int a = 0; a < 2; ++a)
#pragma unroll
        for (int b = 0; b < 2; ++b)
#pragma unroll
            for (int m = 0; m < 4; ++m)
#pragma unroll
                for (int n = 0; n < 2; ++n) t += acc[a][b][m][n];
    const float s = (t[0] + t[1]) + (t[2] + t[3]); if (s == 1.2345e30f) sink[0] = s; } };
struct WJob { const float* W; const float* W2; int ldw, K, nrows, mode; const float* g1; const float* g2; const float* g3; int b1, b2; bf16_t* WT; };
DI void wjob_item(const WJob& J, int item, int lane) {
    const int nblk = J.nrows >> 7, kb = item / nblk, nb = item - kb * nblk, k0 = 64 * kb, n0 = 128 * nb;
    const bool has_gain = (J.g1 != nullptr);
    const float* gp = J.g1 + k0; if (k0 >= J.b2) gp = J.g3 + (k0 - J.b2); else if (k0 >= J.b1) gp = J.g2 + (k0 - J.b1);
    bool fast = false;
    if (J.mode == 0) fast = (n0 + 128 <= J.ldw); else if (J.mode == 1) fast = (n0 + 128 <= C_KR); else if (J.mode == 3) fast = true;
    if (fast) {
        const float* src = J.W + n0 + 2 * lane;
        if (J.mode == 3) src = ((nb & 1) ? J.W2 : J.W) + (nb >> 1) * 128 + 2 * lane;
        bf16_t* dst = J.WT + (size_t)(n0 + 2 * lane) * J.K + k0;
        f32x2 v[64];
#pragma unroll
        for (int j = 0; j < 64; ++j) v[j] = *(const f32x2*)(src + (size_t)(k0 + j) * J.ldw);
        if (has_gain) {
#pragma unroll
            for (int j = 0; j < 64; ++j) v[j] = v[j] * gp[j];
        }
#pragma unroll
        for (int i = 0; i < 2; ++i)
#pragma unroll
            for (int g = 0; g < 8; ++g) {
                u32x4 o; o.x = pk2(v[8 * g][i], v[8 * g + 1][i]); o.y = pk2(v[8 * g + 2][i], v[8 * g + 3][i]); o.z = pk2(v[8 * g + 4][i], v[8 * g + 5][i]); o.w = pk2(v[8 * g + 6][i], v[8 * g + 7][i]);
                *(u32x4*)(dst + (size_t)i * J.K + 8 * g) = o;
            }
    } else {
        for (int q = 0; q < 2; ++q) {
            const int n = n0 + lane + 64 * q;
            int col = -1;
            if (J.mode == 0) { if (n < J.ldw) col = n; }
            else if (J.mode == 1) { if (n < C_KR) col = n; else if (n < NIN) { const int j = n - C_KR; col = C_KR + (j >> 1) + 32 * (j & 1); } }
            else if (J.mode == 2) { if (n < NQ) { const int hd = n / 192, w = n % 192; if (w < 128) col = n; else { const int j = w - 128; col = hd * 192 + 128 + (j >> 1) + 32 * (j & 1); } } }
            bf16_t* dst = J.WT + (size_t)n * J.K + k0;
            const float msk = (col >= 0) ? 1.0f : 0.0f;
            const float* sp = J.W + (size_t)k0 * J.ldw + (col >= 0 ? col : 0);
            float v[64];
#pragma unroll
            for (int j = 0; j < 64; ++j) v[j] = sp[(size_t)j * J.ldw];
#pragma unroll
            for (int j = 0; j < 64; ++j) v[j] *= has_gain ? msk * gp[j] : msk;
#pragma unroll
            for (int g = 0; g < 8; ++g) {
                u32x4 o; o.x = pk2(v[8 * g], v[8 * g + 1]); o.y = pk2(v[8 * g + 2], v[8 * g + 3]); o.z = pk2(v[8 * g + 4], v[8 * g + 5]); o.w = pk2(v[8 * g + 6], v[8 * g + 7]);
                *(u32x4*)(dst + 8 * g) = o;
            }
        }
    }
}
DI void run_wjob(const WJob& J, LAS unsigned char* lds, int gw, int NGW, int lane, int wave) {
    const int nitems = (J.K / 32) * (J.nrows >> 8);
    asm volatile("" : "+s"(NGW));
    for (int it = gw; it < nitems; it += NGW) wjob_item(J, it, lane);
}

#define LDS_BARRIER() do { asm volatile("s_waitcnt lgkmcnt(0)" ::: "memory"); __builtin_amdgcn_s_barrier(); asm volatile("" ::: "memory"); } while (0)
DI int crow(int i, int hh) { return (i & 3) + 8 * (i >> 2) + 4 * hh; }
DI bf16x8 pack8(const f32x16& x, int s) {
    u32x4 p = {pk2(x[8 * s], x[8 * s + 1]), pk2(x[8 * s + 2], x[8 * s + 3]), pk2(x[8 * s + 4], x[8 * s + 5]), pk2(x[8 * s + 6], x[8 * s + 7])};
    return __builtin_bit_cast(bf16x8, p);
}
DI bf16x8 tr_pair(LAS unsigned char* p_lo) {
    const s16x4 lo = __builtin_amdgcn_ds_read_tr16_b64_v4i16((LAS s16x4*)p_lo);
    const s16x4 hi = __builtin_amdgcn_ds_read_tr16_b64_v4i16((LAS s16x4*)(p_lo + 8 * 320));
    return __builtin_shufflevector(lo, hi, 0, 1, 2, 3, 4, 5, 6, 7);
}
constexpr int VPITCH = 320;
constexpr float SB_DEAD = 200.0f;

DI void pv_step(f32x16 (&o)[4], LAS unsigned char* Vs, const bf16x8& pb, int hf, int ks2, int lane) {
    const int i16 = lane & 15, q = i16 >> 2, p = i16 & 3, blk = (lane >> 4) & 1, hh = lane >> 5;
    LAS unsigned char* base = Vs + (32 * hf + 16 * ks2 + 4 * hh + q) * VPITCH + 32 * blk + 8 * p;
#pragma unroll
    for (int db = 0; db < 4; ++db) { const bf16x8 a = tr_pair(base + db * 64); o[db] = MFMA32(a, pb, o[db]); }
}
DI void out_norm_store(f32x16 (&o)[4], float pre, bf16_t* dst_row, int hh) {
    float ss = 0.f;
#pragma unroll
    for (int db = 0; db < 4; ++db)
#pragma unroll
        for (int i = 0; i < 16; ++i) { o[db][i] *= pre; ss += o[db][i] * o[db][i]; }
    ss = pair_sum(ss);
    const float rs = rsqrtf(ss * (1.0f / 128.0f) + EPS);
#pragma unroll
    for (int db = 0; db < 4; ++db)
#pragma unroll
        for (int g = 0; g < 4; ++g) {
            u32x2 w; w.x = pk2(o[db][4 * g] * rs, o[db][4 * g + 1] * rs); w.y = pk2(o[db][4 * g + 2] * rs, o[db][4 * g + 3] * rs);
            *(u32x2*)(dst_row + 32 * db + 8 * g + 4 * hh) = w;
        }
}

DI void sb_item(LAS unsigned char* lds, const bf16_t* P, bf16_t* MIX, int b, int h, int qb, int wave_) {
    const int tid = wave_ * 64 + lane_id();
    const int lane = tid & 63, wave = wave_, r = lane & 31, hh = lane >> 5;
    const size_t tok0 = (size_t)b * SEQ;
    const int tq0 = qb * 256 + wave * 32;
    constexpr int KP = 272;
    LAS unsigned char* Ks = lds; LAS unsigned char* Vs = lds + 64 * KP;
    bf16x8 qf[8];
    { const bf16_t* qp = P + (tok0 + tq0 + r) * PP + C_SQ + h * 128 + hh * 8;
#pragma unroll
      for (int ks = 0; ks < 8; ++ks) qf[ks] = *(const bf16x8*)(qp + ks * 16); }
    f32x16 o[4];
#pragma unroll
    for (int db = 0; db < 4; ++db)
#pragma unroll
        for (int i = 0; i < 16; ++i) o[db][i] = 0.f;
    float carry = 0.f;
    const int ntiles = 4 * qb + 4;
    const float scale = 0.08838834764831845f;
    u32x4 kreg[2], vreg[2];
    const bf16_t* kbase = P + tok0 * PP + C_SK + h * 128;
    const bf16_t* vbase = P + tok0 * PP + C_SV + h * 128;
#define SB_LOAD(kt) do { _Pragma("unroll") for (int i_ = 0; i_ < 2; ++i_) { const int c_ = tid + 512 * i_, row_ = c_ >> 4, col_ = c_ & 15; \
        const size_t go_ = (size_t)((kt) * 64 + row_) * PP + col_ * 8; kreg[i_] = *(const u32x4*)(kbase + go_); vreg[i_] = *(const u32x4*)(vbase + go_); } } while (0)
#define SB_STORE() do { _Pragma("unroll") for (int i_ = 0; i_ < 2; ++i_) { const int c_ = tid + 512 * i_, row_ = c_ >> 4, col_ = c_ & 15; \
        *(LAS u32x4*)(Ks + row_ * KP + col_ * 16) = kreg[i_]; *(LAS u32x4*)(Vs + row_ * VPITCH + col_ * 16) = vreg[i_]; } } while (0)
    LAS unsigned* dflag = (LAS unsigned*)(lds + 40960);
    bool wdead = false;
    if (lane == 0) dflag[wave] = 0u;
    SB_LOAD(ntiles - 1);
    for (int kt = ntiles - 1; kt >= 0; --kt) {
        LDS_BARRIER();
        { unsigned nd = 0u;
#pragma unroll
          for (int w = 0; w < 8; ++w) nd += dflag[w];
          if (nd == 8u) break; }
        SB_STORE();
        LDS_BARRIER();
        if (kt > 0) SB_LOAD(kt - 1);
        if (kt * 64 <= tq0 && !wdead) {
            const int t = tq0 + r;
#pragma unroll
            for (int hf = 1; hf >= 0; --hf) {
                f32x16 acc;
#pragma unroll
                for (int i = 0; i < 16; ++i) acc[i] = 0.f;
#pragma unroll
                for (int ks = 0; ks < 8; ++ks) { const bf16x8 a = *(const LAS bf16x8*)(Ks + (32 * hf + r) * KP + (16 * ks + 8 * hh) * 2); acc = MFMA32(a, qf[ks], acc); }
                const int sbase = kt * 64 + 32 * hf + 4 * hh;
                float lk[16];
#pragma unroll
                for (int i = 0; i < 16; ++i) {
                    const float z = acc[i] * scale;
                    const bool valid = (sbase + (i & 3) + 8 * (i >> 2)) < t;
                    const float e = fexp2(-fabsf(z) * LOG2E);
                    const float sp = fmaxf(z, 0.f) + flog2(1.0f + e) * LN2;
                    lk[i] = valid ? -sp : 0.f;
                    acc[i] = z;
                }
                float G[4], PT[4], GP[4];
#pragma unroll
                for (int g = 0; g < 4; ++g) {
                    G[g] = (lk[4 * g] + lk[4 * g + 1]) + (lk[4 * g + 2] + lk[4 * g + 3]);
                    auto rr = __builtin_amdgcn_permlane32_swap(__float_as_uint(G[g]), __float_as_uint(G[g]), false, false);
                    const float lo = __uint_as_float(rr[0]), up = __uint_as_float(rr[1]);
                    PT[g] = lo + up; GP[g] = hh ? lo : up;
                }
                float running = carry;
#pragma unroll
                for (int g = 3; g >= 0; --g) {
                    const float off = running + (hh == 0 ? GP[g] : 0.f);
                    const float c3 = off + lk[4 * g + 3], c2 = c3 + lk[4 * g + 2], c1 = c2 + lk[4 * g + 1], c0 = c1 + lk[4 * g];
                    acc[4 * g + 3] = ((sbase + 3 + 8 * g) < t) ? fexp2((acc[4 * g + 3] + c3) * LOG2E) : 0.f;
                    acc[4 * g + 2] = ((sbase + 2 + 8 * g) < t) ? fexp2((acc[4 * g + 2] + c2) * LOG2E) : 0.f;
                    acc[4 * g + 1] = ((sbase + 1 + 8 * g) < t) ? fexp2((acc[4 * g + 1] + c1) * LOG2E) : 0.f;
                    acc[4 * g + 0] = ((sbase + 0 + 8 * g) < t) ? fexp2((acc[4 * g + 0] + c0) * LOG2E) : 0.f;
                    running += PT[g];
                }
                carry = running;
#pragma unroll
                for (int ks2 = 0; ks2 < 2; ++ks2) { const bf16x8 pb = pack8(acc, ks2); pv_step(o, Vs, pb, hf, ks2, lane); }
            }
            if (__all(carry < -SB_DEAD)) { wdead = true; if (lane == 0) dflag[wave] = 1u; }
        }
    }
#undef SB_LOAD
#undef SB_STORE
    out_norm_store(o, 1.0f, MIX + (tok0 + tq0 + r) * DM + 512 + h * 128, hh);
}

DI void mla_item(LAS unsigned char* lds, const bf16_t* P, const bf16_t* Q, const bf16_t* KV, bf16_t* MIX, int b, int h, int qb, int wave_) {
    const int tid = wave_ * 64 + lane_id();
    const int lane = tid & 63, wave = wave_, r = lane & 31, hh = lane >> 5;
    const size_t tok0 = (size_t)b * SEQ;
    const int tq0 = qb * 256 + wave * 32;
    constexpr int KP = 400;
    LAS unsigned char* Ks = lds; LAS unsigned char* Vs = lds + 64 * KP;
    bf16x8 qf[12];
    { const bf16_t* qp = Q + (tok0 + tq0 + r) * NQ + h * 192 + hh * 8;
#pragma unroll
      for (int ks = 0; ks < 12; ++ks) qf[ks] = *(const bf16x8*)(qp + ks * 16); }
    f32x16 o[4];
#pragma unroll
    for (int db = 0; db < 4; ++db)
#pragma unroll
        for (int i = 0; i < 16; ++i) o[db][i] = 0.f;
    float m_run = -1e30f, l_run = 0.f;
    const int ntiles = 4 * qb + 4;
    const float C = 0.07216878364870322f * LOG2E;
    u32x4 kreg[2], vreg[2], rreg;
    const bf16_t* kbase = KV + tok0 * NKV + h * 256;
    const bf16_t* rbase = P + tok0 * PP + C_KR;
#define ML_LOAD(kt) do { _Pragma("unroll") for (int i_ = 0; i_ < 2; ++i_) { const int c_ = tid + 512 * i_, row_ = c_ >> 4, col_ = c_ & 15; \
        const size_t go_ = (size_t)((kt) * 64 + row_) * NKV + col_ * 8; kreg[i_] = *(const u32x4*)(kbase + go_); vreg[i_] = *(const u32x4*)(kbase + go_ + 128); } \
        rreg = *(const u32x4*)(rbase + (size_t)((kt) * 64 + (tid >> 3)) * PP + (tid & 7) * 8); } while (0)
#define ML_STORE() do { _Pragma("unroll") for (int i_ = 0; i_ < 2; ++i_) { const int c_ = tid + 512 * i_, row_ = c_ >> 4, col_ = c_ & 15; \
        *(LAS u32x4*)(Ks + row_ * KP + col_ * 16) = kreg[i_]; *(LAS u32x4*)(Vs + row_ * VPITCH + col_ * 16) = vreg[i_]; } \
        *(LAS u32x4*)(Ks + (tid >> 3) * KP + 256 + (tid & 7) * 16) = rreg; } while (0)
    ML_LOAD(0);
    for (int kt = 0; kt < ntiles; ++kt) {
        LDS_BARRIER();
        ML_STORE();
        LDS_BARRIER();
        if (kt + 1 < ntiles) ML_LOAD(kt + 1);
        if (kt <= (tq0 >> 6)) {
            f32x16 s0, s1;
#pragma unroll
            for (int i = 0; i < 16; ++i) { s0[i] = 0.f; s1[i] = 0.f; }
            {
                const LAS unsigned char* k0p = Ks + r * KP + 16 * hh; const LAS unsigned char* k1p = k0p + 32 * KP;
                bf16x8 fa[2], fb[2], na[2], nb[2];
#pragma unroll
                for (int j = 0; j < 2; ++j) { fa[j] = *(const LAS bf16x8*)(k0p + 32 * j); fb[j] = *(const LAS bf16x8*)(k1p + 32 * j); }
#pragma unroll
                for (int g = 0; g < 6; ++g) {
                    if (g < 5) {
#pragma unroll
                        for (int j = 0; j < 2; ++j) { na[j] = *(const LAS bf16x8*)(k0p + 32 * (2 * g + 2 + j)); nb[j] = *(const LAS bf16x8*)(k1p + 32 * (2 * g + 2 + j)); }
                    }
#pragma unroll
                    for (int j = 0; j < 2; ++j) { s0 = MFMA32(fa[j], qf[2 * g + j], s0); s1 = MFMA32(fb[j], qf[2 * g + j], s1); }
                    if (g < 5) {
#pragma unroll
                        for (int j = 0; j < 2; ++j) { fa[j] = na[j]; fb[j] = nb[j]; }
                    }
                    __builtin_amdgcn_sched_barrier(0);
                }
            }
            float mx = s0[0];
#pragma unroll
            for (int i = 1; i < 16; ++i) mx = fmaxf(mx, s0[i]);
#pragma unroll
            for (int i = 0; i < 16; ++i) mx = fmaxf(mx, s1[i]);
            mx = pair_max(mx);
            const float mnew = fmaxf(m_run, mx);
            const float alpha = fexp2((m_run - mnew) * C);
            m_run = mnew;
            const float mc = -mnew * C;
            float ps = 0.f;
#pragma unroll
            for (int i = 0; i < 16; ++i) { s0[i] = fexp2(fmaf(s0[i], C, mc)); s1[i] = fexp2(fmaf(s1[i], C, mc)); ps += s0[i] + s1[i]; }
            ps = pair_sum(ps);
            l_run = l_run * alpha + ps;
            if (!__all(alpha == 1.0f)) {
#pragma unroll
            for (int db = 0; db < 4; ++db)
#pragma unroll
                for (int i = 0; i < 16; ++i) o[db][i] *= alpha;
            }
#pragma unroll
            for (int ks2 = 0; ks2 < 2; ++ks2) { const bf16x8 pb = pack8(s0, ks2); pv_step(o, Vs, pb, 0, ks2, lane); }
#pragma unroll
            for (int ks2 = 0; ks2 < 2; ++ks2) { const bf16x8 pb = pack8(s1, ks2); pv_step(o, Vs, pb, 1, ks2, lane); }
        }
    }
#undef ML_LOAD
#undef ML_STORE
    out_norm_store(o, 1.0f / l_run, MIX + (tok0 + tq0 + r) * DM + 1280 + h * 128, hh);
}

DI void hg_item(LAS unsigned char* lds, const bf16_t* P, bf16_t* MIX, const float* lbs, int layer, int b, int h, int wave_) {
    const int tid = wave_ * 64 + lane_id();
    const int lane = tid & 63, wave = wave_, r = lane & 31, hh = lane >> 5;
    const int k = tid & 127, tq = tid >> 7;
    constexpr int P128 = 272, P64 = 144;
    LAS unsigned char* Qt = lds; LAS unsigned char* Kt = lds + 17408; LAS unsigned char* Qg = lds + 34816;
    LAS unsigned char* KgT = lds + 52224; LAS unsigned char* VT = lds + 70656; LAS unsigned char* Am = lds + 89088; LAS unsigned char* ST = lds + 98304;
    LAS float* tot = (LAS float*)(lds + 133120); LAS float* dec = (LAS float*)(lds + 135168); LAS float* red = (LAS float*)(lds + 135680);
    float lb = 0.f;
    if (layer == 1) { const float a0 = lbs[h * 128 + k], a1 = lbs[512 + h * 128 + k]; lb = 1.0f / (1.0f + __expf(a0 - a1)); }
    const float oml = 1.0f - lb;
    const size_t tok0 = (size_t)b * SEQ;
    LDS_BARRIER();
    for (int i = tid; i < 34816 / 4; i += 512) ((LAS unsigned*)ST)[i] = 0u;
    f32x16 st[2];
#pragma unroll
    for (int j = 0; j < 2; ++j)
#pragma unroll
        for (int i = 0; i < 16; ++i) st[j][i] = 0.f;
    u32x4 rawq[2], rawf[2]; u32x4 vld[2]; u32x2 gpre[4];
    const bf16_t* qrow = P + tok0 * PP + C_HQ + h * 128;
    const bf16_t* vbase = P + tok0 * PP + C_HV + h * 128;
    const bf16_t* gbase = P + (tok0 + 32 * (wave >> 2) + r) * PP + C_HG + h * 128 + 32 * (wave & 3) + 4 * hh;
    u32x2 gnext[4];
#define HG_LOAD(c) do { _Pragma("unroll") for (int i_ = 0; i_ < 2; ++i_) { const int c_ = tid + 512 * i_; \
            { const int row_ = c_ >> 4, col_ = c_ & 15; const bf16_t* p_ = qrow + (size_t)((c) * 64 + row_) * PP + col_ * 8; rawq[i_] = *(const u32x4*)p_; rawf[i_] = *(const u32x4*)(p_ + 512); } \
            { const int s_ = c_ & 63, v0_ = (c_ >> 6) * 8; vld[i_] = *(const u32x4*)(vbase + (size_t)((c) * 64 + s_) * PP + v0_); } } \
        _Pragma("unroll") for (int g_ = 0; g_ < 4; ++g_) gnext[g_] = *(const u32x2*)(gbase + (size_t)((c) * 64) * PP + 8 * g_); } while (0)
    HG_LOAD(0);
    for (int c = 0; c < 32; ++c) {
#pragma unroll
        for (int g = 0; g < 4; ++g) gpre[g] = gnext[g];
#pragma unroll
        for (int i = 0; i < 2; ++i) { const int c_ = tid + 512 * i, row_ = c_ >> 4, col_ = c_ & 15;
            *(LAS u32x4*)(Qt + row_ * P128 + col_ * 16) = rawq[i]; *(LAS u32x4*)(Kt + row_ * P128 + col_ * 16) = rawf[i]; }
        LDS_BARRIER();
        for (int dupA = 0; dupA < HGA_REPS; ++dupA) {
        float lf[16], kk[16]; float cs = 0.f;
#pragma unroll
        for (int i = 0; i < 16; ++i) {
            const float fp = bf2f(*(const LAS unsigned short*)(Kt + (16 * tq + i) * P128 + k * 2));
            const float e = fexp2(-fp * LOG2E);
            const float sg = __builtin_amdgcn_rcpf(1.0f + e);
            const float sn = (e > 1e30f) ? 1.0f : e * sg;
            const float f = lb + oml * sg;
            cs += flog2(fmaxf(f, 1e-37f)) * LN2; lf[i] = cs; kk[i] = oml * sn;
        }
        tot[tq * 128 + k] = cs;
        LDS_BARRIER();
        const float t0 = tot[k], t1 = tot[128 + k], t2 = tot[256 + k], t3 = tot[384 + k];
        const float offs = (tq > 0 ? t0 : 0.f) + (tq > 1 ? t1 : 0.f) + (tq > 2 ? t2 : 0.f);
        const float gref = t0 + t1, gl = (t0 + t1) + (t2 + t3);
#pragma unroll
        for (int i = 0; i < 16; ++i) {
            const float g = offs + lf[i]; const int t = 16 * tq + i; const float qv = bf2f(*(const LAS unsigned short*)(Qt + t * P128 + k * 2));
            const float e1 = fexp2(fminf(g - gref, 80.f) * LOG2E), e2 = fexp2(g * LOG2E), e3 = fexp2(fminf(gref - g, 80.f) * LOG2E), e4 = fexp2((gl - g) * LOG2E);
            *(LAS unsigned short*)(Qt + t * P128 + k * 2) = (unsigned short)pk2(qv * e1, 0.f);
            *(LAS unsigned short*)(Qg + t * P128 + k * 2) = (unsigned short)pk2(qv * e2, 0.f);
            *(LAS unsigned short*)(Kt + t * P128 + k * 2) = (unsigned short)pk2(kk[i] * e3, 0.f);
            *(LAS unsigned short*)(KgT + k * P64 + t * 2) = (unsigned short)pk2(kk[i] * e4, 0.f);
        }
        if (tq == 0) dec[k] = fexp2(gl * LOG2E);
#pragma unroll
        for (int i = 0; i < 2; ++i) { const int c_ = tid + 512 * i, s_ = c_ & 63, v0_ = (c_ >> 6) * 8;
            const unsigned w[4] = {vld[i].x, vld[i].y, vld[i].z, vld[i].w};
#pragma unroll
            for (int j = 0; j < 4; ++j) { *(LAS unsigned short*)(VT + (v0_ + 2 * j) * P64 + s_ * 2) = (unsigned short)(w[j] & 0xffffu); *(LAS unsigned short*)(VT + (v0_ + 2 * j + 1) * P64 + s_ * 2) = (unsigned short)(w[j] >> 16); } }
        LDS_BARRIER();
        }
        if (c + 1 < 32) HG_LOAD(c + 1);
        if (wave < 4) {
            const int sb = wave & 1, tb = wave >> 1;
            f32x16 x;
#pragma unroll
            for (int i = 0; i < 16; ++i) x[i] = 0.f;
            if (sb <= tb) {
#pragma unroll
                for (int ks = 0; ks < 8; ++ks) { const bf16x8 a = *(const LAS bf16x8*)(Kt + (32 * sb + r) * P128 + (16 * ks + 8 * hh) * 2); const bf16x8 bq = *(const LAS bf16x8*)(Qt + (32 * tb + r) * P128 + (16 * ks + 8 * hh) * 2); x = MFMA32(a, bq, x); }
            }
            const int t = 32 * tb + r;
#pragma unroll
            for (int g = 0; g < 4; ++g) {
                float v[4];
#pragma unroll
                for (int j = 0; j < 4; ++j) { const int s = 32 * sb + 8 * g + 4 * hh + j; v[j] = (s <= t && sb <= tb) ? x[4 * g + j] : 0.f; }
                u32x2 w; w.x = pk2(v[0], v[1]); w.y = pk2(v[2], v[3]);
                *(LAS u32x2*)(Am + t * P64 + (32 * sb + 8 * g + 4 * hh) * 2) = w;
            }
        }
        LDS_BARRIER();
        const int vb = wave & 3, tb2 = wave >> 2;
        f32x16 acc;
#pragma unroll
        for (int i = 0; i < 16; ++i) acc[i] = 0.f;
#pragma unroll
        for (int ks = 0; ks < 4; ++ks) { const bf16x8 a = *(const LAS bf16x8*)(VT + (32 * vb + r) * P64 + (16 * ks + 8 * hh) * 2); const bf16x8 bb = *(const LAS bf16x8*)(Am + (32 * tb2 + r) * P64 + (16 * ks + 8 * hh) * 2); acc = MFMA32(a, bb, acc); }
#pragma unroll
        for (int ks = 0; ks < 8; ++ks) { const bf16x8 a = *(const LAS bf16x8*)(ST + (32 * vb + r) * P128 + (16 * ks + 8 * hh) * 2); const bf16x8 bb = *(const LAS bf16x8*)(Qg + (32 * tb2 + r) * P128 + (16 * ks + 8 * hh) * 2); acc = MFMA32(a, bb, acc); }
        const int kb = wave >> 1;
#pragma unroll
        for (int j = 0; j < 2; ++j) {
            const int vb2 = 2 * (wave & 1) + j;
#pragma unroll
            for (int i = 0; i < 16; ++i) st[j][i] *= dec[32 * kb + crow(i, hh)];
#pragma unroll
            for (int ks = 0; ks < 4; ++ks) { const bf16x8 a = *(const LAS bf16x8*)(KgT + (32 * kb + r) * P64 + (16 * ks + 8 * hh) * 2); const bf16x8 bb = *(const LAS bf16x8*)(VT + (32 * vb2 + r) * P64 + (16 * ks + 8 * hh) * 2); st[j] = MFMA32(a, bb, st[j]); }
        }
        { float ss = 0.f;
#pragma unroll
          for (int i = 0; i < 16; ++i) ss += acc[i] * acc[i];
          ss = pair_sum(ss);
          if (hh == 0) red[(32 * tb2 + r) * 4 + vb] = ss; }
        LDS_BARRIER();
#pragma unroll
        for (int j = 0; j < 2; ++j) { const int vb2 = 2 * (wave & 1) + j;
#pragma unroll
            for (int g = 0; g < 4; ++g) { u32x2 w; w.x = pk2(st[j][4 * g], st[j][4 * g + 1]); w.y = pk2(st[j][4 * g + 2], st[j][4 * g + 3]);
                *(LAS u32x2*)(ST + (32 * vb2 + r) * P128 + (32 * kb + 8 * g + 4 * hh) * 2) = w; } }
        { const int t = 32 * tb2 + r; const LAS float* rp = red + t * 4;
          const float ssq = (rp[0] + rp[1]) + (rp[2] + rp[3]);
          const float rs = rsqrtf(ssq * (1.0f / 128.0f) + EPS);
          const size_t tok = tok0 + c * 64 + t;
          bf16_t* op = MIX + tok * DM + h * 128 + 32 * vb + 4 * hh;
#pragma unroll
          for (int g = 0; g < 4; ++g) {
              const u32x2 gw = gpre[g];
              const float g0 = bflo(gw.x), g1 = bfhi(gw.x), g2 = bflo(gw.y), g3 = bfhi(gw.y);
              const float y0 = acc[4 * g] * rs * g0 * __builtin_amdgcn_rcpf(1.0f + fexp2(-g0 * LOG2E));
              const float y1 = acc[4 * g + 1] * rs * g1 * __builtin_amdgcn_rcpf(1.0f + fexp2(-g1 * LOG2E));
              const float y2 = acc[4 * g + 2] * rs * g2 * __builtin_amdgcn_rcpf(1.0f + fexp2(-g2 * LOG2E));
              const float y3 = acc[4 * g + 3] * rs * g3 * __builtin_amdgcn_rcpf(1.0f + fexp2(-g3 * LOG2E));
              u32x2 w; w.x = pk2(y0, y1); w.y = pk2(y2, y3);
              *(u32x2*)(op + 8 * g) = w;
          } }
    }
#undef HG_LOAD
    LDS_BARRIER();
}


#define XB_TMO      128
#define XB_XCNT(j)  (256  + 64 * (j))
#define XB_XSUB(j)  (1280 + 64 * (j))
#define XB_XGEN(j)  (2304 + 64 * (j))
#define XB_TOP      3328
#define XB_TOPGEN   3392
#define XCD_BAR_WORDS 3456
#define XB_SPIN_CAP (1u << 18)
DI unsigned xb_ld(unsigned* p)              { return __hip_atomic_load(p, __ATOMIC_RELAXED, __HIP_MEMORY_SCOPE_AGENT); }
DI unsigned xb_add(unsigned* p, unsigned v) { return __hip_atomic_fetch_add(p, v, __ATOMIC_RELAXED, __HIP_MEMORY_SCOPE_AGENT); }
DI unsigned xb_xcc_id() { return (unsigned)__builtin_amdgcn_s_getreg((3 << 11) | 20) & 0xFu; }
#define XB_SPIN(cond, bar) do { unsigned _sp = 0; while (cond) { __builtin_amdgcn_s_sleep(1); \
    if ((++_sp & 255u) == 0u) { if (xb_ld(&(bar)[XB_TMO])) break; if (_sp > XB_SPIN_CAP) { atomicAdd(&(bar)[XB_TMO], 1u); break; } } } } while (0)
DI void xcd_barrier_complete(unsigned* bar, unsigned x, unsigned& nloc, unsigned& nx, unsigned G) {
    unsigned sum, cnt, mine, sp = 0u;
    for (;;) {
        sum = 0u; cnt = 0u; mine = 0u;
#pragma unroll
        for (unsigned j = 0; j < 16; ++j) { const unsigned c = xb_ld(&bar[XB_XCNT(j)]); sum += c; cnt += (c > 0u) ? 1u : 0u; mine = (j == x) ? c : mine; }
        if (sum == G) break;
        __builtin_amdgcn_s_sleep(1);
        if ((++sp & 255u) == 0u) { if (xb_ld(&bar[XB_TMO])) break; if (sp > XB_SPIN_CAP) { atomicAdd(&bar[XB_TMO], 1u); break; } }
    }
    nloc = mine > 0u ? mine : 1u; nx = cnt > 0u ? cnt : 1u;
}
DI void xcd_barrier(unsigned* bar, volatile LAS unsigned* st, bool t0, unsigned total) {
    asm volatile("s_waitcnt vmcnt(0)" ::: "memory");
    LDS_BARRIER();
    if (t0) {
        const unsigned x = xb_xcc_id();
        __builtin_amdgcn_s_waitcnt(0);
        unsigned nloc = st[0], nx = st[1];
        if (nloc == 0u) { xcd_barrier_complete(bar, x, nloc, nx, total); st[0] = nloc; st[1] = nx; }
        const unsigned old = xb_add(&bar[XB_XSUB(x)], 1u);
        const unsigned gen = old / nloc;
        if (old + 1u == (gen + 1u) * nloc) {
            __builtin_amdgcn_fence(__ATOMIC_RELEASE, "agent");
            asm volatile("s_waitcnt vmcnt(0)" ::: "memory");
            const unsigned og = xb_add(&bar[XB_TOP], 1u);
            const unsigned tg = og / nx;
            if (og + 1u == (tg + 1u) * nx) xb_add(&bar[XB_TOPGEN], 1u);
            else XB_SPIN(xb_ld(&bar[XB_TOPGEN]) == tg, bar);
            __builtin_amdgcn_fence(__ATOMIC_ACQUIRE, "agent");
            xb_add(&bar[XB_XGEN(x)], 1u);
            asm volatile("s_waitcnt vmcnt(0)" ::: "memory");
        } else {
            XB_SPIN(xb_ld(&bar[XB_XGEN(x)]) == gen, bar);
            __builtin_amdgcn_fence(__ATOMIC_ACQUIRE, "agent");
            asm volatile("s_waitcnt vmcnt(0)" ::: "memory");
        }
    }
    LDS_BARRIER();
}
constexpr size_t CTL_BAR = 20 * 65536;
#ifndef USE_CG_SYNC
#define GBAR() xcd_barrier((unsigned*)(ARGS()->ws + WS_CTL + CTL_BAR), (volatile LAS unsigned*)(lds + LDS_QWORD + 16), (wave == 0 && lane_id() == 0), (unsigned)G)
#define SUBBAR() xcd_barrier((unsigned*)(ARGS()->ws + WS_CTL + CTL_BAR + 16384), (volatile LAS unsigned*)(lds + LDS_QWORD + 24), (wave == 0 && lane_id() == 0), (unsigned)(G - NHG))
constexpr int NHG = 32;
DI void xcc_local_barrier(unsigned* bar, bool t0, unsigned nloc) {
    asm volatile("" : "+s"(nloc));
    asm volatile("s_waitcnt vmcnt(0)" ::: "memory");
    __syncthreads();
    if (t0) {
        const unsigned x = xb_xcc_id();
        __builtin_amdgcn_s_waitcnt(0);
        const unsigned old = xb_add(&bar[XB_XSUB(x)], 1u);
        const unsigned gen = old / nloc;
        if (old + 1u == (gen + 1u) * nloc) xb_add(&bar[XB_XGEN(x)], 1u);
        else XB_SPIN(xb_ld(&bar[XB_XGEN(x)]) == gen, bar);
        __builtin_amdgcn_fence(__ATOMIC_ACQUIRE, "agent");
        asm volatile("s_waitcnt vmcnt(0)" ::: "memory");
    }
    __syncthreads();
}
#define VC_ID() (((volatile LAS unsigned*)(lds + LDS_QWORD + 32))[1] ? (int)__builtin_amdgcn_readfirstlane((int)((volatile LAS unsigned*)(lds + LDS_QWORD + 32))[0]) : (int)blockIdx.x)
#define LBAR() do { if (((volatile LAS unsigned*)(lds + LDS_QWORD + 32))[1]) xcc_local_barrier((unsigned*)(ARGS()->ws + WS_CTL + CTL_BAR + 32768), (wave == 0 && lane_id() == 0), (unsigned)(G / 8)); else GBAR(); } while (0)
#else
#define GBAR() grid.sync()
#endif

struct Args { const float* in[18]; const int* pos; float* out; unsigned char* ws; };

typedef const __attribute__((address_space(4))) Args* ArgsP;
#define ARGS() ({ ArgsP p_ = (ArgsP)__builtin_amdgcn_kernarg_segment_ptr(); asm volatile("" : "+s"(p_)); p_; })

#ifdef PROBE_I1
#define STAMP(k) do { if (blockIdx.x == 0 && wave == 0 && lane_id() == 0) { ArgsP sp_ = ARGS(); ((unsigned long long*)(sp_->ws + WS_CTL + 29 * 65536))[k] = __builtin_amdgcn_s_memrealtime(); } } while (0)
#else
#define STAMP(k) do { } while (0)
#endif
__global__ void __launch_bounds__(512, 2) mega(Args a_unused) {
    extern __shared__ __attribute__((aligned(16))) unsigned char lds_raw[];
    LAS unsigned char* lds = (LAS unsigned char*)lds_raw;
    cg::grid_group grid = cg::this_grid();
    const int wave = __builtin_amdgcn_readfirstlane((int)threadIdx.x >> 6) & 7;
    const int G = gridDim.x;
    const int vcu = (G % 8 == 0) ? ((int)blockIdx.x % 8) * (G / 8) + (int)blockIdx.x / 8 : (int)blockIdx.x;
    const int gw = vcu * 8 + wave, NGW = G * 8;
    if (wave == 0) { const int l0 = lane_id(); if (l0 < 8) ((LAS unsigned*)(lds + LDS_QWORD + 16))[l0] = 0u; }
    __syncthreads();
    STAMP(0);

    for (int l = 0; l < 2; ++l) {
        for (int stage = l; stage < 2; ++stage) {
            if (stage == 1) {
            {
                ArgsP ap = ARGS(); unsigned char* ws = ap->ws; ssq_t* ssq = (ssq_t*)(ws + WS_CTL);
                pg8::Gemm g{(const bf16_t*)(ws + WS_XB), (const bf16_t*)(ws + WS_WL + (size_t)l * WL_SIZE + WL_IN), M, NINP, DM, DM}; pg8::StaticOrder S; S.init(M, 5120, G, VC_ID());
                EpiIn E{(bf16_t*)(ws + WS_BIG), ssq + (SSQ_IN0 + l) * 16384, ssq + (SSQ_Q0 + l) * 16384, ssq + (SSQ_KV0 + l) * 16384, ap->pos};
                pg8::gemm_phase<EpiIn, true>(lds, g, S, E, wave);
    #ifdef P1_DUP
                { EpiIn E2 = E; E2.ssq_q = (ssq_t*)(ws + WS_CTL + 22 * 65536); E2.ssq_kv = (ssq_t*)(ws + WS_CTL + 24 * 65536); pg8::gemm_phase<EpiIn>(lds, g, S, E2, wave); }
    #endif
            }
            }
            ArgsP ap = ARGS(); unsigned char* ws = ap->ws;
            int llane = lane_id(); asm volatile("" : "+v"(llane));
            const int ltid = wave * 64 + llane;
            const int ntot = (stage == 0) ? 7552 : ((l == 0) ? 2816 : 2048);
            unsigned* cq = (unsigned*)(ws + WS_CTL + CTL_QCTR) + 16 + l;
            int ngw_w = NGW; asm volatile("" : "+s"(ngw_w));
            for (int wrep = 0; wrep < W_REPS; ++wrep)
            for (int it = (stage == 0) ? gw : 0;; ) {
                if (stage == 1) { int t_ = 0; if (llane == 0) t_ = (int)atomicAdd(cq, 1u); it = __builtin_amdgcn_readfirstlane(t_); }
                if (it >= ntot) break;
                int gi;
                if (stage == 0) gi = (it < 3328) ? it : it + 640;
                else if (l == 0) gi = 8192 + it;
                else gi = (it < 640) ? 3328 + it : 11008 + (it - 640);
                int j, base;
                if (gi < 1984) { if (gi < 1344) { j = 0; base = 0; } else if (gi < 1424) { j = 1; base = 1344; } else if (gi < 1472) { j = 2; base = 1424; } else { j = 3; base = 1472; } }
                else if (gi < 3968) { if (gi < 3328) { j = 4; base = 1984; } else if (gi < 3408) { j = 5; base = 3328; } else if (gi < 3456) { j = 6; base = 3408; } else { j = 7; base = 3456; } }
                else if (gi < 6784) { j = 8; base = 3968; } else if (gi < 8192) { j = 9; base = 6784; } else if (gi < 11008) { j = 10; base = 8192; } else { j = 11; base = 11008; }
                WJob J;
                const int jl = (j < 8) ? (j >> 2) : (j - 8) >> 1, jt = (j < 8) ? (j & 3) : 4 + ((j - 8) & 1);
                unsigned char* wlj = ws + WS_WL + (size_t)jl * WL_SIZE;
                J.W2 = nullptr; J.g2 = nullptr; J.g3 = nullptr;
                if (jt == 0) { J.W = ap->in[3] + (size_t)jl * DM * NIN; J.ldw = NIN; J.K = DM; J.nrows = NINP; J.mode = 1; J.g1 = ap->in[2] + jl * DM; J.b1 = DM; J.b2 = DM; J.WT = (bf16_t*)(wlj + WL_IN); }
                else if (jt == 1) { J.W = ap->in[8] + (size_t)jl * 512 * NQ; J.ldw = NQ; J.K = 512; J.nrows = NQP; J.mode = 2; J.g1 = ap->in[7] + jl * 512; J.b1 = 512; J.b2 = 512; J.WT = (bf16_t*)(wlj + WL_UQ); }
                else if (jt == 2) { J.W = ap->in[10] + (size_t)jl * 256 * NKV; J.ldw = NKV; J.K = 256; J.nrows = NKV; J.mode = 0; J.g1 = ap->in[9] + jl * 256; J.b1 = 256; J.b2 = 256; J.WT = (bf16_t*)(wlj + WL_UKV); }
                else if (jt == 3) { J.W = ap->in[12] + (size_t)jl * DM * DM; J.ldw = DM; J.K = DM; J.nrows = DM; J.mode = 0; J.g1 = ap->in[5] + jl * 512; J.g2 = ap->in[6] + jl * 768; J.g3 = ap->in[11] + jl * 768; J.b1 = 512; J.b2 = 1280; J.WT = (bf16_t*)(wlj + WL_O); }
                else if (jt == 4) { J.W = ap->in[14] + (size_t)jl * DM * DFF; J.W2 = ap->in[15] + (size_t)jl * DM * DFF; J.ldw = DFF; J.K = DM; J.nrows = 2 * DFF; J.mode = 3; J.g1 = ap->in[13] + jl * DM; J.b1 = DM; J.b2 = DM; J.WT = (jl == 0) ? (bf16_t*)(ws + WS_WGU) : (bf16_t*)((unsigned char*)ap->out + DO_WGU1); }
                else { J.W = ap->in[16] + (size_t)jl * DFF * DM; J.ldw = DM; J.K = DFF; J.nrows = DM; J.mode = 0; J.g1 = nullptr; J.b1 = 0; J.b2 = 0; J.WT = (jl == 0) ? (bf16_t*)(ws + WS_WDN) : (bf16_t*)((unsigned char*)ap->out + DO_WDN1); }
                wjob_item(J, gi - base, llane);
                if (stage == 0) it += ngw_w;
            }
            if (stage == 0) {
                ssq_t* ssq = (ssq_t*)(ws + WS_CTL); unsigned* qctr = (unsigned*)(ws + WS_CTL + CTL_QCTR);
                const float* x_in = ap->in[0]; bf16_t* XB = (bf16_t*)(ws + WS_XB);
                int zstride = G * 512, ngw = NGW; asm volatile("" : "+s"(zstride), "+s"(ngw));
                ssq_t zero64 = 0ull; asm volatile("" : "+v"(zero64));
                for (int i = (int)blockIdx.x * 512 + ltid; i < (SSQ_N - 1) * 16384; i += zstride) ssq[16384 + i] = zero64;
                if (blockIdx.x == 0 && ltid < 64) qctr[ltid] = 0u;
                if (blockIdx.x == 1) { unsigned* bw = (unsigned*)(ws + WS_CTL + CTL_BAR); for (int i = ltid; i < 16384; i += 512) bw[i] = 0u; }
                for (int m = gw; m < M; m += ngw) {
                    const f32x4* xr = (const f32x4*)(x_in + (size_t)m * DM) + llane;
                    u32x2* o8 = (u32x2*)(XB + (size_t)m * DM) + llane;
                    float s = 0.f;
#pragma unroll
                    for (int jj = 0; jj < 8; ++jj) { const f32x4 v = xr[64 * jj]; s += (v.x * v.x + v.y * v.y) + (v.z * v.z + v.w * v.w); u32x2 w; w.x = pk2(v.x, v.y); w.y = pk2(v.z, v.w); o8[64 * jj] = w; }
                    s = wave_sum64(s);
                    if (llane == 0) ssq[SSQ_IN0 * 16384 + m] = (ssq_t)(s * 16777216.0f);
                }
                grid.sync();
                if (wave == 0 && lane_id() == 0) { const unsigned xcc_ = xb_xcc_id(); const unsigned rank_ = xb_add(&((unsigned*)(ws + WS_CTL + CTL_BAR))[XB_XCNT(xcc_)], 1u);
                    ((volatile LAS unsigned*)(lds + LDS_QWORD + 32))[0] = xcc_ + 8u * rank_;
                    if ((int)blockIdx.x >= NHG) (void)xb_add(&((unsigned*)(ws + WS_CTL + CTL_BAR + 16384))[XB_XCNT(xb_xcc_id())], 1u); }
                STAMP(1);
            }
        }
        GBAR();
        if (l == 0) {
            if (wave == 0 && lane_id() == 0) { unsigned* bw_ = (unsigned*)(ARGS()->ws + WS_CTL + CTL_BAR); unsigned ok_ = ((G & 7) == 0) ? 1u : 0u;
                for (unsigned j = 0; j < 8; ++j) ok_ &= (xb_ld(&bw_[XB_XCNT(j)]) == (unsigned)(G / 8)) ? 1u : 0u;
                ((volatile LAS unsigned*)(lds + LDS_QWORD + 32))[1] = ok_; }
            __syncthreads();
        }
        STAMP(2 + 6 * l + 0);
        {
            const unsigned aff = (unsigned)__builtin_amdgcn_readfirstlane((int)((volatile LAS unsigned*)(lds + LDS_QWORD + 32))[1]);
            const int vcid = VC_ID();
            int is_hg, hb, hhd, cq_, ckv_, xcc_; bool do_kv = true; int gkv = G - NHG;
            if (aff) { const int rank = vcid >> 3; xcc_ = vcid & 7; is_hg = rank < 4; hb = xcc_; hhd = rank & 3; cq_ = (xcc_ + 8 * (rank - 4)) & 0xffff; ckv_ = (xcc_ + 8 * (rank - 16)) & 0xffff; do_kv = (rank >= 16); gkv = (G - NHG) - 12 * 8; }
            else { int bid = (int)blockIdx.x; asm volatile("" : "+s"(bid)); xcc_ = 0; is_hg = bid < NHG; hb = bid >> 2; hhd = bid & 3; cq_ = (bid - NHG) & 0xffff; ckv_ = (G - 1 - bid) & 0xffff; }
            if (is_hg) {
                ArgsP ap = ARGS(); unsigned char* ws = ap->ws;
                hg_item(lds, (const bf16_t*)(ws + WS_BIG), (bf16_t*)(ws + WS_MIX), ap->in[4], l, hb, hhd, wave);
            } else {
                {
                    ArgsP ap = ARGS(); unsigned char* ws = ap->ws; ssq_t* ssq = (ssq_t*)(ws + WS_CTL);
                    pg8::Gemm g{(const bf16_t*)(ws + WS_BIG) + C_CQ, (const bf16_t*)(ws + WS_WL + (size_t)l * WL_SIZE + WL_UQ), M, NQP, 512, PP}; pg8::StaticOrder S; S.init(M, NQP, G - NHG, cq_);
                    EpiQ E{(bf16_t*)ap->out, ssq + (SSQ_Q0 + l) * 16384, ap->pos};
                    for (int rep = 0; rep < P2_REPS; ++rep) pg8::gemm_phase<EpiQ>(lds, g, S, E, wave);
                }
                {
                    ArgsP ap = ARGS(); unsigned char* ws = ap->ws; ssq_t* ssq = (ssq_t*)(ws + WS_CTL);
                    pg8::Gemm g{(const bf16_t*)(ws + WS_BIG) + C_CKV, (const bf16_t*)(ws + WS_WL + (size_t)l * WL_SIZE + WL_UKV), M, NKV, 256, PP}; pg8::StaticOrder S; S.init(M, NKV, gkv, ckv_);
                    EpiKV E{(bf16_t*)(ws + WS_KV), ssq + (SSQ_KV0 + l) * 16384};
                    if (do_kv) pg8::gemm_phase<EpiKV>(lds, g, S, E, wave);
                }
                if (aff) xcc_local_barrier((unsigned*)(ARGS()->ws + WS_CTL + CTL_BAR + 49152), (wave == 0 && lane_id() == 0), (unsigned)((G - NHG) / 8)); else SUBBAR();
                STAMP(2 + 6 * l + 1);
            }
            {
                ArgsP ap = ARGS(); unsigned char* ws = ap->ws;
                unsigned* qall = (unsigned*)(ws + WS_CTL + CTL_QCTR);
                unsigned* qmla = aff ? (qall + 32 + 16 * l + xcc_) : (qall + 4 * l);
                unsigned* qsb = aff ? (qall + 40 + 16 * l + xcc_) : (qall + 4 * l + 1);
                const int nitems = aff ? 48 : 384, per = aff ? 6 : 48;
                const bf16_t* Pb = (const bf16_t*)(ws + WS_BIG); const bf16_t* MQ = (const bf16_t*)ap->out; const bf16_t* KVb = (const bf16_t*)(ws + WS_KV); bf16_t* MIX = (bf16_t*)(ws + WS_MIX);
                LAS unsigned* qw = (LAS unsigned*)(lds + LDS_QWORD);
                bool mla_open = !is_hg;
                for (;;) {
                    __syncthreads();
                    if (wave == 0 && lane_id() == 0) *qw = atomicAdd(mla_open ? qmla : qsb, 1u);
                    __syncthreads();
                    const int item = (int)*qw;
                    if (item >= nitems) { if (mla_open) { mla_open = false; continue; } break; }
                    const int qb = 7 - item / per, rem = item % per, bb = aff ? xcc_ : rem / 6, hd = rem % 6;
                    if (mla_open) mla_item(lds, Pb, MQ, KVb, MIX, bb, hd, qb, wave); else sb_item(lds, Pb, MIX, bb, hd, qb, wave);
                }
            }
        }
        LBAR();
        STAMP(2 + 6 * l + 2);
        {
            ArgsP ap = ARGS(); unsigned char* ws = ap->ws; ssq_t* ssq = (ssq_t*)(ws + WS_CTL);
            pg8::Gemm g{(const bf16_t*)(ws + WS_MIX), (const bf16_t*)(ws + WS_WL + (size_t)l * WL_SIZE + WL_O), M, DM, DM, DM}; pg8::StaticOrder S; S.init(M, DM, G, VC_ID());
            EpiRes E{(bf16_t*)(ws + WS_XB), ssq + (SSQ_F0 + l) * 16384};
            pg8::gemm_phase<EpiRes>(lds, g, S, E, wave);
        }
        LBAR();
        STAMP(2 + 6 * l + 3);
        {
            ArgsP ap = ARGS(); unsigned char* ws = ap->ws; ssq_t* ssq = (ssq_t*)(ws + WS_CTL);
            pg8::Gemm g{(const bf16_t*)(ws + WS_XB), (l == 0) ? (const bf16_t*)(ws + WS_WGU) : (const bf16_t*)((const unsigned char*)ap->out + DO_WGU1), M, 2 * DFF, DM, DM}; pg8::StaticOrder S; S.init(M, 2 * DFF, G, VC_ID(), 8);
            EpiGU E{(bf16_t*)(ws + WS_BIG), ssq + (SSQ_F0 + l) * 16384};
            pg8::gemm_phase<EpiGU>(lds, g, S, E, wave);
#ifdef PROBE_NOEPI
            { EpiNone EN{(float*)(ws + WS_CTL + 31 * 65536)}; pg8::gemm_phase<EpiNone>(lds, g, S, EN, wave); }
#endif
        }
        LBAR();
        STAMP(2 + 6 * l + 4);
        {
            ArgsP ap = ARGS(); unsigned char* ws = ap->ws; ssq_t* ssq = (ssq_t*)(ws + WS_CTL);
            pg8::Gemm g{(const bf16_t*)(ws + WS_BIG), (l == 0) ? (const bf16_t*)(ws + WS_WDN) : (const bf16_t*)((const unsigned char*)ap->out + DO_WDN1), M, DM, DFF, DFF}; pg8::StaticOrder S; S.init(M, DM, G, VC_ID());
            EpiRes E{(bf16_t*)(ws + WS_XB), ssq + ((l == 0) ? SSQ_IN1 : SSQ_FIN) * 16384};
            pg8::gemm_phase<EpiRes>(lds, g, S, E, wave);
        }
        if (l == 0) LBAR(); else GBAR();
        STAMP(2 + 6 * l + 5);
    }
#ifdef PROBE_SYNC
    for (int i = 0; i < 20; ++i) grid.sync();
#endif
    {
        ArgsP ap = ARGS(); const ssq_t* ssq = (const ssq_t*)(ap->ws + WS_CTL);
        const float* gf = ap->in[17]; float* out = ap->out; const bf16_t* XB = (const bf16_t*)(ap->ws + WS_XB);
        int lane = lane_id(); asm volatile("" : "+v"(lane));
        int ngw = NGW; asm volatile("" : "+s"(ngw));
        for (int m = gw; m < M; m += ngw) {
            const u32x4* xi = (const u32x4*)(XB + (size_t)m * DM) + lane;
            f32x4* o = (f32x4*)(out + (size_t)m * DM) + 2 * lane;
            const float rs = rsqrtf(ssq_get(ssq + SSQ_FIN * 16384, m) * (1.0f / DM) + EPS);
#pragma unroll
            for (int j = 0; j < 4; ++j) {
                const u32x4 w = xi[64 * j];
                const f32x4 g0 = ((const f32x4*)gf)[2 * lane + 128 * j], g1 = ((const f32x4*)gf)[2 * lane + 128 * j + 1];
                o[128 * j] = (f32x4){bflo(w.x), bfhi(w.x), bflo(w.y), bfhi(w.y)} * rs * g0;
                o[128 * j + 1] = (f32x4){bflo(w.z), bfhi(w.z), bflo(w.w), bfhi(w.w)} * rs * g1;
            }
        }
    }
#ifdef PROBE_I1
    grid.sync();
    STAMP(14);
    if (blockIdx.x == 0) {
        ArgsP ap = ARGS(); const unsigned long long* st = (const unsigned long long*)(ap->ws + WS_CTL + 29 * 65536);
        __syncthreads();
        const float T1 = (float)(st[PROBE_I1 + 1] - st[PROBE_I1]) * 0.01f, T2 = (float)(st[PROBE_I2 + 1] - st[PROBE_I2]) * 0.01f;
        const int n2 = (int)T2; const float V = T1 * 1000.0f;
        for (int j = wave * 64 + lane_id(); j < n2; j += 512) ap->out[j] = V;
    }
#endif
}

extern "C" void kernel_launch(void* const* d_in, const int* in_sizes, int n_in, void* d_out, int out_size, void* d_ws, size_t ws_size, hipStream_t stream) {
    static int grid = 0;
    if (grid == 0) {
        int dev = 0, cus = 0, per_cu = 0;
        (void)hipGetDevice(&dev);
        (void)hipDeviceGetAttribute(&cus, hipDeviceAttributeMultiprocessorCount, dev);
        (void)hipFuncSetAttribute((const void*)mega, hipFuncAttributeMaxDynamicSharedMemorySize, LDS_BYTES);
        (void)hipOccupancyMaxActiveBlocksPerMultiprocessor(&per_cu, (const void*)mega, 512, LDS_BYTES);
        grid = cus > 0 ? cus : 256;
        if (ws_size < WS_END) { fprintf(stderr, "kernel_launch: workspace too small: %zu < %zu\n", ws_size, (size_t)WS_END); grid = -1; }
        fprintf(stderr, "kernel_launch: cus %d per_cu %d grid %d ws %zu\n", cus, per_cu, grid, ws_size);
    }
    if (grid < 0) return;
    Args a{};
    for (int i = 0; i < 18; ++i) a.in[i] = (const float*)d_in[i];
    a.pos = (const int*)d_in[1];
    a.out = (float*)d_out; a.ws = (unsigned char*)d_ws;
    void* args[] = {&a};
    hipError_t e = hipLaunchCooperativeKernel((const void*)mega, dim3(grid), dim3(512), args, LDS_BYTES, stream);
    if (e != hipSuccess) fprintf(stderr, "cooperative launch failed: %s\n", hipGetErrorString(e));
}
```
